# Optimizing an MI355X kernel written in HIP

```python
import math
import jax
import jax.numpy as jnp
from jax import lax
import numpy as np


D_MODEL = 1024
BATCH = 8
SEQ = 8192
DEPTH = 1

CTX_LEN = 256
GRID_W = 64
EPS = 1e-6
CHUNK = 64
D_MIX = D_MODEL
ML_HEADS = 4
ML_QK = D_MIX // 16
ML_V = D_MIX // 8
GD_HEADS = 4
GD_QK = D_MIX // 8
GD_V = D_MIX // 8
CONV_W = 5
ML_SIZES = (ML_HEADS * ML_QK, ML_HEADS * ML_QK, ML_HEADS * ML_V, ML_HEADS * ML_V, 4 * ML_HEADS)
GD_SIZES = (GD_HEADS * (2 * GD_QK + GD_V), GD_HEADS * GD_V, 4 * GD_HEADS)
ML_COLS = sum(ML_SIZES)
GD_COLS = sum(GD_SIZES)
D_IN = ML_COLS + GD_COLS
N_EXPERTS = 256
TOP_K = 8
N_GROUPS = 8
TOPK_GROUPS = 4
D_EXPERT = D_MODEL // 4
D_SHARED = D_MODEL // 4
ROUTED_SCALE = 2.5
EXPERT_BLOCK = 128

kernel_name = 'hybrid_mlstm_gdn_moe_dit_layer'


def rms_norm(t, w):
    tf = t.astype(jnp.float32)
    tf = tf * lax.rsqrt(jnp.mean(tf * tf, axis=-1, keepdims=True) + EPS)
    return (tf * w.astype(jnp.float32)).astype(t.dtype)


def l2norm(t):
    tf = t.astype(jnp.float32)
    return tf * lax.rsqrt(jnp.sum(tf * tf, axis=-1, keepdims=True) + EPS)


def modulate(t, shift, scale):
    return t * (1 + scale) + shift


def split_cols(t, sizes):
    return jnp.split(t, np.cumsum(sizes)[:-1].tolist(), axis=-1)


def split_heads(t, n_heads):
    b, l, hd = t.shape
    return t.reshape(b, l, n_heads, hd // n_heads).transpose(0, 2, 1, 3)


def head_rms_norm(t, w):
    t = t * lax.rsqrt(jnp.mean(t * t, axis=-1, keepdims=True) + EPS)
    t = t.transpose(0, 2, 1, 3) * w.astype(jnp.float32)
    b, l, h, d = t.shape
    return t.reshape(b, l, h * d)


def to_chunks(t):
    b, h, l = t.shape[:3]
    return jnp.moveaxis(t.reshape(b, h, l // CHUNK, CHUNK, *t.shape[3:]), 2, 0)


def from_chunks(t):
    t = jnp.moveaxis(t, 0, 2)
    return t.reshape(t.shape[0], t.shape[1], -1, *t.shape[4:])


def raster_to_colmajor(t, rows):
    b, l, ch = t.shape
    return t.reshape(b, rows, GRID_W, ch).transpose(0, 2, 1, 3).reshape(b, l, ch)


def colmajor_to_raster(t, rows):
    b, l, ch = t.shape
    return t.reshape(b, GRID_W, rows, ch).transpose(0, 2, 1, 3).reshape(b, l, ch)


def centred_dwconv(t, w):
    pad = CONV_W // 2
    return lax.conv_general_dilated(t, w.astype(t.dtype)[:, None, :], window_strides=(1,), padding=[(pad, pad)],
                                    dimension_numbers=('NWC', 'WIO', 'NWC'), feature_group_count=t.shape[-1])


def mlstm_scan(q, k, v, i_pre, f_pre, state):
    f32 = jnp.float32
    qc, kc, vc = (to_chunks(t.astype(f32)) for t in (q, k, v))
    ic = to_chunks(i_pre.astype(f32))
    bc = jnp.cumsum(to_chunks(jax.nn.log_sigmoid(f_pre.astype(f32))), axis=-1)
    causal = jnp.tril(jnp.ones((CHUNK, CHUNK), dtype=bool))

    def step(carry, xs):
        C, n, m = carry
        qb, kb, vb, bb, ib = xs
        log_d = jnp.where(causal, bb[..., :, None] - bb[..., None, :] + ib[..., None, :], -jnp.inf)
        log_prev = bb + m[..., None]
        m_t = jnp.maximum(log_prev, jnp.max(log_d, axis=-1))
        s = jnp.einsum('bhtd,bhsd->bhts', qb, kb) * jnp.exp(log_d - m_t[..., None])
        w_prev = jnp.exp(log_prev - m_t)
        num = jnp.einsum('bhts,bhsv->bhtv', s, vb) + w_prev[..., None] * jnp.einsum('bhtd,bhdv->bhtv', qb, C)
        den = jnp.sum(s, axis=-1) + w_prev * jnp.einsum('bhtd,bhd->bht', qb, n)
        h = num / jnp.maximum(jnp.abs(den), jnp.exp(-m_t))[..., None]
        b_end = bb[..., -1]
        log_s = b_end[..., None] - bb + ib
        m_new = jnp.maximum(b_end + m, jnp.max(log_s, axis=-1))
        w_s = jnp.exp(log_s - m_new[..., None])
        w_c = jnp.exp(b_end + m - m_new)
        C = w_c[..., None, None] * C + jnp.einsum('bhs,bhsd,bhsv->bhdv', w_s, kb, vb)
        n = w_c[..., None] * n + jnp.einsum('bhs,bhsd->bhd', w_s, kb)
        return (C, n, m_new), h

    state, h = lax.scan(step, state, (qc, kc, vc, bc, ic))
    return from_chunks(h), state


def gated_delta_scan(q, k, v, g, beta, S):
    f32 = jnp.float32
    qc = to_chunks(q.astype(f32)) * GD_QK ** -0.5
    kc, vc = to_chunks(k.astype(f32)), to_chunks(v.astype(f32))
    bc = to_chunks(beta.astype(f32))
    G = jnp.cumsum(to_chunks(g.astype(f32)), axis=-1)
    incl = jnp.tril(jnp.ones((CHUNK, CHUNK), dtype=bool))
    strict = jnp.tril(jnp.ones((CHUNK, CHUNK), dtype=bool), -1)
    decay = jnp.exp(jnp.where(incl, G[..., :, None] - G[..., None, :], -jnp.inf))
    kk = jnp.einsum('nbhtd,nbhsd->nbhts', kc, kc)
    A = jnp.eye(CHUNK, dtype=f32) + jnp.where(strict, bc[..., :, None] * kk * decay, 0.0)
    rhs = jnp.concatenate([vc * bc[..., None], kc * (bc * jnp.exp(G))[..., None]], axis=-1)
    uw = lax.linalg.triangular_solve(A, rhs, left_side=True, lower=True, unit_diagonal=True)
    u, w = uw[..., :GD_V], uw[..., GD_V:]
    qk = jnp.einsum('nbhtd,nbhsd->nbhts', qc, kc) * decay

    def step(S, xs):
        qb, kb, ub, wb, Gb, qkb = xs
        v_new = ub - jnp.einsum('bhtd,bhdv->bhtv', wb, S)
        o = jnp.einsum('bhtd,bhdv->bhtv', qb * jnp.exp(Gb)[..., None], S) + jnp.einsum('bhts,bhsv->bhtv', qkb, v_new)
        g_end = Gb[..., -1]
        S = S * jnp.exp(g_end)[..., None, None] + jnp.einsum('bhsd,bhs,bhsv->bhdv', kb, jnp.exp(g_end[..., None] - Gb), v_new)
        return S, o

    S, o = lax.scan(step, S, (qc, kc, u, w, G, qk))
    return from_chunks(o), S


def bidir_scan(scan_fn, ctx_in, lat_in, init_state, with_ctx_out):
    ctx_out, lat_out = None, None
    for d in range(2):
        c_in, l_in = ctx_in[d], lat_in[d]
        if d == 1:
            c_in = tuple(jnp.flip(t, axis=2) for t in c_in)
            l_in = tuple(jnp.flip(t, axis=2) for t in l_in)
        c_h, c_state = scan_fn(*c_in, init_state)
        l_h, _ = scan_fn(*l_in, c_state)
        if d == 1:
            c_h, l_h = jnp.flip(c_h, axis=2), jnp.flip(l_h, axis=2)
        lat_out = l_h if lat_out is None else lat_out + l_h
        if with_ctx_out:
            ctx_out = c_h if ctx_out is None else ctx_out + c_h
    return ctx_out, lat_out


def mlstm_group(p_ctx, p_lat, i_bias, f_bias, norm_w, with_ctx_out):
    def prep(p):
        b, l, _ = p.shape
        q, k, v, o, gates = split_cols(p, ML_SIZES)
        gates = gates.reshape(b, l, 2, 2, ML_HEADS).transpose(2, 3, 0, 4, 1)
        q = split_heads(q, ML_HEADS)
        k = split_heads(k, ML_HEADS) * ML_QK ** -0.5
        v = split_heads(v, ML_HEADS)
        per_dir = tuple((q, k, v, gates[d, 0] + i_bias[d][:, None], gates[d, 1] + f_bias[d][:, None]) for d in range(2))
        return per_dir, o

    ctx_in, o_ctx = prep(p_ctx)
    lat_in, o_lat = prep(p_lat)
    b = p_lat.shape[0]
    init = (jnp.zeros((b, ML_HEADS, ML_QK, ML_V), jnp.float32), jnp.zeros((b, ML_HEADS, ML_QK), jnp.float32),
            jnp.zeros((b, ML_HEADS), jnp.float32))
    h_ctx, h_lat = bidir_scan(mlstm_scan, ctx_in, lat_in, init, with_ctx_out)
    gain = norm_w.reshape(ML_HEADS, ML_V)

    def out(h, o):
        return (head_rms_norm(h, gain) * jax.nn.sigmoid(o.astype(jnp.float32))).astype(o.dtype)

    return (out(h_ctx, o_ctx) if with_ctx_out else None), out(h_lat, o_lat)


def gdn_group(p_ctx, p_lat, conv_w, a_log, dt_bias, norm_w, with_ctx_out):
    def prep(p):
        b, l, _ = p.shape
        qkv, z, gates = split_cols(p, GD_SIZES)
        qkv = jax.nn.silu(centred_dwconv(qkv, conv_w))
        q, k, v = split_cols(qkv, (GD_HEADS * GD_QK, GD_HEADS * GD_QK, GD_HEADS * GD_V))
        q, k, v = l2norm(split_heads(q, GD_HEADS)), l2norm(split_heads(k, GD_HEADS)), split_heads(v, GD_HEADS)
        gates = gates.reshape(b, l, 2, 2, GD_HEADS).transpose(2, 3, 0, 4, 1).astype(jnp.float32)
        per_dir = tuple((q, k, v,
                         -jnp.exp(a_log[d].astype(jnp.float32))[:, None] * jax.nn.softplus(gates[d, 0] + dt_bias[d][:, None]),
                         jax.nn.sigmoid(gates[d, 1])) for d in range(2))
        return per_dir, z

    ctx_in, z_ctx = prep(p_ctx)
    lat_in, z_lat = prep(p_lat)
    init = jnp.zeros((p_lat.shape[0], GD_HEADS, GD_QK, GD_V), jnp.float32)
    o_ctx, o_lat = bidir_scan(gated_delta_scan, ctx_in, lat_in, init, with_ctx_out)

    def out(o, z):
        return (head_rms_norm(o, norm_w) * jax.nn.silu(z.astype(jnp.float32))).astype(z.dtype)

    return (out(o_ctx, z_ctx) if with_ctx_out else None), out(o_lat, z_lat)


def hybrid_mixer(h_ctx, h_lat, w_in, w_out, ml_i_bias, ml_f_bias, ml_norm_w, gd_conv_w, gd_a_log, gd_dt_bias,
                 gd_norm_w, with_ctx_out):
    rows = h_lat.shape[1] // GRID_W
    p_ctx = h_ctx @ w_in
    p_lat = h_lat @ w_in
    gd_lat = raster_to_colmajor(p_lat[..., ML_COLS:], rows)
    ml_y_ctx, ml_y_lat = mlstm_group(p_ctx[..., :ML_COLS], p_lat[..., :ML_COLS], ml_i_bias, ml_f_bias, ml_norm_w,
                                     with_ctx_out)
    gd_y_ctx, gd_y_lat = gdn_group(p_ctx[..., ML_COLS:], gd_lat, gd_conv_w, gd_a_log, gd_dt_bias, gd_norm_w,
                                   with_ctx_out)
    y_lat = jnp.concatenate([ml_y_lat, colmajor_to_raster(gd_y_lat, rows)], axis=-1) @ w_out
    y_ctx = jnp.concatenate([ml_y_ctx, gd_y_ctx], axis=-1) @ w_out if with_ctx_out else None
    return y_ctx, y_lat


def moe_ffn(h, router_w, router_bias, w_gate, w_up, w_down, ws_gate, ws_up, ws_down):
    b, l, d = h.shape
    n_tok = b * l
    xf = h.reshape(n_tok, d)
    scores = jax.nn.sigmoid((xf @ router_w).astype(jnp.float32))
    sel = scores + router_bias.astype(jnp.float32)
    grp_score = lax.top_k(sel.reshape(n_tok, N_GROUPS, N_EXPERTS // N_GROUPS), 2)[0].sum(-1)
    _, top_grp = lax.top_k(grp_score, TOPK_GROUPS)
    grp_mask = jnp.any(top_grp[:, :, None] == jnp.arange(N_GROUPS)[None, None, :], axis=1)
    sel = jnp.where(jnp.repeat(grp_mask, N_EXPERTS // N_GROUPS, axis=1), sel, -jnp.inf)
    _, idx = lax.top_k(sel, TOP_K)
    gate = jnp.take_along_axis(scores, idx, axis=1)
    gate = gate / jnp.sum(gate, axis=-1, keepdims=True) * ROUTED_SCALE
    n_asg = n_tok * TOP_K
    flat_e = idx.reshape(-1)
    order = jnp.argsort(flat_e)
    se = flat_e[order]
    st = (order // TOP_K).astype(jnp.int32)
    sw = gate.reshape(-1)[order]
    counts = jnp.bincount(flat_e, length=N_EXPERTS)
    padded = (counts + EXPERT_BLOCK - 1) // EXPERT_BLOCK * EXPERT_BLOCK
    start = jnp.cumsum(counts) - counts
    pend = jnp.cumsum(padded)
    dest = (pend - padded)[se] + jnp.arange(n_asg) - start[se]
    n_blocks = -(-n_asg // EXPERT_BLOCK) + N_EXPERTS
    row_tok = jnp.zeros((n_blocks * EXPERT_BLOCK,), jnp.int32).at[dest].set(st)
    row_w = jnp.zeros((n_blocks * EXPERT_BLOCK,), jnp.float32).at[dest].set(sw)
    block_e = jnp.minimum(jnp.searchsorted(pend, jnp.arange(n_blocks) * EXPERT_BLOCK, side='right'), N_EXPERTS - 1)

    def expert_block(y, xs):
        e, toks, wts = xs
        xb = xf[toks]
        hb = jax.nn.silu(xb @ w_gate[e]) * (xb @ w_up[e])
        return y.at[toks].add((hb @ w_down[e]) * wts[:, None].astype(y.dtype)), None

    y_shared = (jax.nn.silu(xf @ ws_gate) * (xf @ ws_up)) @ ws_down
    y, _ = lax.scan(expert_block, y_shared,
                    (block_e, row_tok.reshape(n_blocks, EXPERT_BLOCK), row_w.reshape(n_blocks, EXPERT_BLOCK)))
    return y.reshape(b, l, d)


def setup_inputs(seed: int = 0) -> dict:
    key = jax.random.key(seed)
    ks = jax.random.split(key, 27)
    f32 = jnp.float32

    def nrm(k, shape, scale):
        return jax.random.normal(k, shape, f32) * scale

    def gain(k, shape):
        return 1.0 + 0.05 * jax.random.normal(k, shape, f32)

    L = DEPTH
    dt = jnp.exp(jax.random.uniform(ks[16], (L, 2, GD_HEADS), f32, math.log(1e-3), math.log(1e-1)))
    return {
        'x': nrm(ks[0], (BATCH, SEQ, D_MODEL), 1.0),
        'c': nrm(ks[1], (BATCH, D_MODEL), 1.0),
        'ctx': nrm(ks[2], (BATCH, CTX_LEN, D_MODEL), 1.0),
        'c_ctx': nrm(ks[3], (D_MODEL,), 1.0),
        'w_ada': nrm(ks[4], (L, D_MODEL, 6 * D_MODEL), 0.5 * D_MODEL ** -0.5),
        'b_ada': nrm(ks[5], (L, 6 * D_MODEL), 0.02),
        'norm_pre_mix': gain(ks[6], (L, D_MODEL)),
        'norm_post_mix': gain(ks[7], (L, D_MODEL)),
        'norm_pre_ffn': gain(ks[8], (L, D_MODEL)),
        'norm_post_ffn': gain(ks[9], (L, D_MODEL)),
        'w_in': nrm(ks[10], (L, D_MODEL, D_IN), D_MODEL ** -0.5),
        'ml_i_bias': nrm(ks[11], (L, 2, ML_HEADS), 0.1),
        'ml_f_bias': 3.0 + 3.0 * jax.random.uniform(ks[12], (L, 2, ML_HEADS), f32),
        'ml_norm_w': gain(ks[13], (L, ML_HEADS * ML_V)),
        'gd_conv_w': nrm(ks[14], (L, CONV_W, GD_SIZES[0]), CONV_W ** -0.5),
        'gd_a_log': jnp.log(jax.random.uniform(ks[15], (L, 2, GD_HEADS), f32, 1.0, 16.0)),
        'gd_dt_bias': dt + jnp.log(-jnp.expm1(-dt)),
        'gd_norm_w': gain(ks[17], (L, GD_V)),
        'w_out': nrm(ks[18], (L, D_MIX, D_MODEL), D_MIX ** -0.5),
        'router_w': nrm(ks[19], (L, D_MODEL, N_EXPERTS), D_MODEL ** -0.5),
        'router_bias': nrm(ks[20], (L, N_EXPERTS), 0.01),
        'w_gate': nrm(ks[21], (L, N_EXPERTS, D_MODEL, D_EXPERT), D_MODEL ** -0.5),
        'w_up': nrm(ks[22], (L, N_EXPERTS, D_MODEL, D_EXPERT), D_MODEL ** -0.5),
        'w_down': nrm(ks[23], (L, N_EXPERTS, D_EXPERT, D_MODEL), D_EXPERT ** -0.5),
        'ws_gate': nrm(ks[24], (L, D_MODEL, D_SHARED), D_MODEL ** -0.5),
        'ws_up': nrm(ks[25], (L, D_MODEL, D_SHARED), D_MODEL ** -0.5),
        'ws_down': nrm(ks[26], (L, D_SHARED, D_MODEL), D_SHARED ** -0.5),
    }


def reference(x, c, ctx, c_ctx, w_ada, b_ada, norm_pre_mix, norm_post_mix, norm_pre_ffn, norm_post_ffn, w_in,
              ml_i_bias, ml_f_bias, ml_norm_w, gd_conv_w, gd_a_log, gd_dt_bias, gd_norm_w, w_out, router_w,
              router_bias, w_gate, w_up, w_down, ws_gate, ws_up, ws_down):
    ctx_s = ctx
    for layer in range(DEPTH):
        last = layer == DEPTH - 1
        mod = jnp.split((jax.nn.silu(c) @ w_ada[layer] + b_ada[layer])[:, None, :], 6, axis=-1)
        mod_ctx = jnp.split(jax.nn.silu(c_ctx) @ w_ada[layer] + b_ada[layer], 6, axis=-1)
        h_lat = modulate(rms_norm(x, norm_pre_mix[layer]), mod[0], mod[1])
        h_ctx = modulate(rms_norm(ctx_s, norm_pre_mix[layer]), mod_ctx[0], mod_ctx[1])
        y_ctx, y_lat = hybrid_mixer(h_ctx, h_lat, w_in[layer], w_out[layer], ml_i_bias[layer], ml_f_bias[layer],
                                    ml_norm_w[layer], gd_conv_w[layer], gd_a_log[layer], gd_dt_bias[layer],
                                    gd_norm_w[layer], not last)
        x = x + mod[2] * rms_norm(y_lat, norm_post_mix[layer])
        h_ffn = modulate(rms_norm(x, norm_pre_ffn[layer]), mod[3], mod[4])
        y_ffn = moe_ffn(h_ffn, router_w[layer], router_bias[layer], w_gate[layer], w_up[layer], w_down[layer],
                        ws_gate[layer], ws_up[layer], ws_down[layer])
        x = x + mod[5] * rms_norm(y_ffn, norm_post_ffn[layer])
        if not last:
            ctx_s = ctx_s + mod_ctx[2] * rms_norm(y_ctx, norm_post_mix[layer])
            h_c = modulate(rms_norm(ctx_s, norm_pre_ffn[layer]), mod_ctx[3], mod_ctx[4])
            y_c = moe_ffn(h_c, router_w[layer], router_bias[layer], w_gate[layer], w_up[layer], w_down[layer],
                          ws_gate[layer], ws_up[layer], ws_down[layer])
            ctx_s = ctx_s + mod_ctx[5] * rms_norm(y_c, norm_post_ffn[layer])
    return x
```

```cpp
#include <hip/hip_runtime.h>
#include <cstdio>
#include <cstdint>

#ifndef N_LAUNCH_MODE
#define N_LAUNCH_MODE 0
#endif

#define LAS __attribute__((address_space(3)))
typedef unsigned short bf16;
typedef float f32x4 __attribute__((ext_vector_type(4)));

constexpr int NB = 8, SEQ = 8192, D = 1024, CTXL = 256, GW_ = 64, ROWS = SEQ / GW_;
constexpr int T = NB * SEQ, TC = NB * CTXL, TT = T + TC;
constexpr int DIN = 3616;
constexpr int NE = 256, TOPK = 8, NGRP = 8, DE = 256;
constexpr float EPS = 1e-6f;
constexpr int NTHR = 512, NWAVE = 8;
constexpr int NPHASE = 16;

constexpr size_t MiB = 1u << 20;
constexpr size_t WS_CTL = 0, CTL_ZERO_BYTES = 1 * MiB;
constexpr size_t WS_MOD = 1 * MiB;
constexpr size_t WS_IDX = 2 * MiB;
constexpr size_t WS_GWT = 4 * MiB;
constexpr size_t WS_LTOK = 6 * MiB;
constexpr size_t WS_LW = 8 * MiB;
constexpr size_t WS_RT = 10 * MiB;
constexpr size_t WS_GATES = 12 * MiB;
constexpr size_t WS_A = 21 * MiB;
constexpr size_t WS_H = WS_A, WS_PQK = WS_A + 132 * MiB, WS_PV = WS_PQK + 66 * MiB;
constexpr size_t WS_HML = WS_H, WS_YMIX = WS_PQK, WS_HF32 = WS_A, WS_Y = WS_A;
constexpr size_t WS_PO = WS_A + 264 * MiB;
constexpr size_t WS_LOG = WS_PO, WS_GUS = WS_PO;
constexpr size_t WS_B = WS_PO + 66 * MiB;
constexpr size_t WS_RAW = WS_B, WS_PZ = WS_B + 198 * MiB, WS_QKVP = WS_PZ + 66 * MiB;
constexpr size_t WS_OGD = WS_RAW, WS_YLAT = WS_QKVP, WS_GU = WS_B;
constexpr size_t WS_END = WS_B + 512 * MiB;

constexpr int CW_BAR = 4096;
constexpr int CW_CNT = 16384;
constexpr int CW_FILL = 16384 + 256;
constexpr int CW_OFF = 16384 + 512;
constexpr int CW_NRT = 16384 + 1024;

__device__ __forceinline__ float bf2f(bf16 v) { return __uint_as_float(((unsigned)v) << 16); }
__device__ __forceinline__ bf16 f2bf(float f) { unsigned u = __float_as_uint(f); u += 0x7fffu + ((u >> 16) & 1u); return (bf16)(u >> 16); }
__device__ __forceinline__ float sigmoidf_(float x) { return 1.0f / (1.0f + __expf(-x)); }
__device__ __forceinline__ float siluf_(float x) { return x / (1.0f + __expf(-x)); }
__device__ __forceinline__ float softplusf_(float x) { return x > 20.f ? x : log1pf(__expf(x)); }
__device__ __forceinline__ float wave_sum(float v) {
#pragma unroll
    for (int o = 1; o < 64; o <<= 1) v += __shfl_xor(v, o);
    return v;
}

#define XB_TMO      128
#define XB_XCNT(j)  (256  + 64 * (j))
#define XB_XSUB(j)  (1280 + 64 * (j))
#define XB_XGEN(j)  (2304 + 64 * (j))
#define XB_TOP      3328
#define XB_TOPGEN   3392
#define XCD_BAR_WORDS 3456
#define XB_SPIN_CAP (1u << 18)
__device__ __forceinline__ unsigned xb_ld(unsigned* p)              { return __hip_atomic_load(p, __ATOMIC_RELAXED, __HIP_MEMORY_SCOPE_AGENT); }
__device__ __forceinline__ unsigned xb_add(unsigned* p, unsigned v) { return __hip_atomic_fetch_add(p, v, __ATOMIC_RELAXED, __HIP_MEMORY_SCOPE_AGENT); }
__device__ __forceinline__ unsigned xb_xcc_id() { return (unsigned)__builtin_amdgcn_s_getreg((3 << 11) | 20) & 0xFu; }
#define XB_SPIN(cond, bar) do { unsigned _sp = 0; while (cond) { __builtin_amdgcn_s_sleep(1); \
    if ((++_sp & 255u) == 0u) { if (xb_ld(&(bar)[XB_TMO])) break; if (_sp > XB_SPIN_CAP) { atomicAdd(&(bar)[XB_TMO], 1u); break; } } } } while (0)
struct XcdBarrier { unsigned* bar; unsigned x; volatile LAS unsigned* st; };
__device__ __forceinline__ XcdBarrier xcd_barrier_post(unsigned* bar, volatile LAS unsigned* st) {
    XcdBarrier b; b.bar = bar; b.x = xb_xcc_id(); b.st = st;
    if (threadIdx.x == 0) (void)xb_add(&bar[XB_XCNT(b.x)], 1u);
    return b;
}
__device__ __forceinline__ void xcd_barrier_complete(unsigned* bar, unsigned x, unsigned& nloc, unsigned& nx) {
    const unsigned G = gridDim.x * gridDim.y * gridDim.z;
    unsigned sum, cnt, mine, sp = 0u;
    for (;;) {
        sum = 0u; cnt = 0u; mine = 0u;
#pragma unroll
        for (unsigned j = 0; j < 16; ++j) { const unsigned c = xb_ld(&bar[XB_XCNT(j)]); sum += c; cnt += (c > 0u) ? 1u : 0u; mine = (j == x) ? c : mine; }
        if (sum == G) break;
        __builtin_amdgcn_s_sleep(1);
        if ((++sp & 255u) == 0u) { if (xb_ld(&bar[XB_TMO])) break; if (sp > XB_SPIN_CAP) { atomicAdd(&bar[XB_TMO], 1u); break; } }
    }
    nloc = mine > 0u ? mine : 1u; nx = cnt > 0u ? cnt : 1u;
}
__device__ __forceinline__ void xcd_barrier(const XcdBarrier& b) {
    asm volatile("s_waitcnt vmcnt(0)" ::: "memory");
    __syncthreads();
    if (threadIdx.x == 0) {
        unsigned* bar = b.bar;
        __builtin_amdgcn_s_waitcnt(0);
        unsigned nloc = b.st[0], nx = b.st[1];
        if (nloc == 0u) { xcd_barrier_complete(bar, b.x, nloc, nx); b.st[0] = nloc; b.st[1] = nx; }
        const unsigned old = xb_add(&bar[XB_XSUB(b.x)], 1u);
        const unsigned gen = old / nloc;
        if (old + 1u == (gen + 1u) * nloc) {
            __builtin_amdgcn_fence(__ATOMIC_RELEASE, "agent");
            asm volatile("s_waitcnt vmcnt(0)" ::: "memory");
            const unsigned og = xb_add(&bar[XB_TOP], 1u);
            const unsigned tg = og / nx;
            if (og + 1u == (tg + 1u) * nx) xb_add(&bar[XB_TOPGEN], 1u);
            else XB_SPIN(xb_ld(&bar[XB_TOPGEN]) == tg, bar);
            __builtin_amdgcn_fence(__ATOMIC_ACQUIRE, "agent");
            xb_add(&bar[XB_XGEN(b.x)], 1u);
            asm volatile("s_waitcnt vmcnt(0)" ::: "memory");
        } else {
            XB_SPIN(xb_ld(&bar[XB_XGEN(b.x)]) == gen, bar);
            __builtin_amdgcn_fence(__ATOMIC_ACQUIRE, "agent");
            asm volatile("s_waitcnt vmcnt(0)" ::: "memory");
        }
    }
    __syncthreads();
}

struct Args { const float* in[27]; float* out; unsigned char* ws; int ph_lo, ph_hi; };
enum { I_X = 0, I_C, I_CTX, I_CCTX, I_WADA, I_BADA, I_NPM, I_NQM, I_NPF, I_NQF, I_WIN, I_MLIB, I_MLFB, I_MLNW, I_GDCW, I_GDAL, I_GDDT, I_GDNW,
       I_WOUT, I_RW, I_RB, I_WG, I_WU, I_WD, I_WSG, I_WSU, I_WSD };

constexpr int GT = 128, GK = 16, GAP = GT + 4;
template <class AF, class BF, class EF>
__device__ __forceinline__ void ngemm_tile(int m0, int n0, int Mlim, int N, int K, const AF& af, const BF& bf, const EF& ef, LAS float* As, LAS float* Bs) {
    const int tid = threadIdx.x, ty = tid >> 4, tx = tid & 15;
    float acc[4][8];
#pragma unroll
    for (int i = 0; i < 4; ++i)
#pragma unroll
        for (int j = 0; j < 8; ++j) acc[i][j] = 0.f;
    for (int k0 = 0; k0 < K; k0 += GK) {
        float av[4], bv[4];
#pragma unroll
        for (int i = 0; i < 4; ++i) { const int idx = tid + i * NTHR; const int r = idx >> 4, kk = idx & 15; av[i] = (m0 + r < Mlim) ? af(m0 + r, k0 + kk) : 0.f; }
#pragma unroll
        for (int i = 0; i < 4; ++i) { const int idx = tid + i * NTHR; const int kk = idx >> 7, c = idx & 127; bv[i] = (n0 + c < N) ? bf(k0 + kk, n0 + c) : 0.f; }
        __syncthreads();
#pragma unroll
        for (int i = 0; i < 4; ++i) { const int idx = tid + i * NTHR; const int r = idx >> 4, kk = idx & 15; As[kk * GAP + r] = av[i]; }
#pragma unroll
        for (int i = 0; i < 4; ++i) { const int idx = tid + i * NTHR; const int kk = idx >> 7, c = idx & 127; Bs[kk * GT + c] = bv[i]; }
        __syncthreads();
#pragma unroll
        for (int kk = 0; kk < GK; ++kk) {
            const f32x4 a = *(const LAS f32x4*)(As + kk * GAP + ty * 4);
            const f32x4 b0 = *(const LAS f32x4*)(Bs + kk * GT + tx * 8), b1 = *(const LAS f32x4*)(Bs + kk * GT + tx * 8 + 4);
#pragma unroll
            for (int i = 0; i < 4; ++i) {
#pragma unroll
                for (int j = 0; j < 4; ++j) { acc[i][j] += a[i] * b0[j]; acc[i][4 + j] += a[i] * b1[j]; }
            }
        }
    }
#pragma unroll
    for (int i = 0; i < 4; ++i) { const int m = m0 + ty * 4 + i; if (m < Mlim) {
#pragma unroll
        for (int j = 0; j < 8; ++j) { const int n = n0 + tx * 8 + j; if (n < N) ef(m, n, acc[i][j]); } } }
    __syncthreads();
}

__global__ void __launch_bounds__(NTHR, 2) fwd(Args args) {
    extern __shared__ __attribute__((aligned(16))) unsigned char lds_raw[];
    LAS unsigned char* lds = (LAS unsigned char*)lds_raw;
    const int tid = threadIdx.x, lane = tid & 63, wave = __builtin_amdgcn_readfirstlane(tid >> 6);
    const int G = gridDim.x, bid = blockIdx.x;
    const int gw = bid * NWAVE + wave, NGW = G * NWAVE;
    unsigned char* ws = args.ws;
    unsigned* ctl = (unsigned*)(ws + WS_CTL);
    float* MOD = (float*)(ws + WS_MOD);
    int* IDX = (int*)(ws + WS_IDX); float* GWT = (float*)(ws + WS_GWT);
    int* LTOK = (int*)(ws + WS_LTOK); float* LW = (float*)(ws + WS_LW);
    int* RT = (int*)(ws + WS_RT);
    float* GATES = (float*)(ws + WS_GATES);
    bf16* H = (bf16*)(ws + WS_H); bf16* PQK = (bf16*)(ws + WS_PQK); bf16* PV = (bf16*)(ws + WS_PV); bf16* PO = (bf16*)(ws + WS_PO);
    bf16* RAW = (bf16*)(ws + WS_RAW); bf16* PZ = (bf16*)(ws + WS_PZ); bf16* QKVP = (bf16*)(ws + WS_QKVP);
    bf16* HML = (bf16*)(ws + WS_HML); bf16* OGD = (bf16*)(ws + WS_OGD); bf16* YMIX = (bf16*)(ws + WS_YMIX); bf16* YLAT = (bf16*)(ws + WS_YLAT);
    float* HF32 = (float*)(ws + WS_HF32); float* Y = (float*)(ws + WS_Y); float* LOG = (float*)(ws + WS_LOG);
    bf16* GUS = (bf16*)(ws + WS_GUS); bf16* GU = (bf16*)(ws + WS_GU);
    const float* x = args.in[I_X]; float* out = args.out;

    volatile LAS unsigned* MISC = (volatile LAS unsigned*)(lds + 65536);
    if (tid < 16) MISC[tid] = 0u;
    __syncthreads();
    XcdBarrier bar; bar.bar = ctl + CW_BAR; bar.x = 0; bar.st = nullptr;
    if (N_LAUNCH_MODE == 1) bar = xcd_barrier_post(ctl + CW_BAR, MISC + 8);
    const int lo = args.ph_lo, hi = args.ph_hi;
#define IN(k) (lo <= (k) && (k) < hi)
#define SEAM(k) do { if (N_LAUNCH_MODE == 1 && IN(k) && IN((k) + 1)) xcd_barrier(bar); } while (0)

    if (IN(0)) {
        LAS float* sc = (LAS float*)lds;
        LAS float* part = sc + 9 * 1024;
        const float* c = args.in[I_C]; const float* cctx = args.in[I_CCTX]; const float* wada = args.in[I_WADA]; const float* bada = args.in[I_BADA];
        for (int i = tid; i < 9 * 1024; i += NTHR) { const float v = (i < 8 * 1024) ? c[i] : cctx[i - 8 * 1024]; sc[i] = siluf_(v); }
        __syncthreads();
        for (int it = bid; it < 96; it += G) {
            const int col = it * 64 + lane;
            float acc[9];
#pragma unroll
            for (int r = 0; r < 9; ++r) acc[r] = 0.f;
            for (int k = wave * 128; k < wave * 128 + 128; ++k) {
                const float w = wada[(size_t)k * 6144 + col];
#pragma unroll
                for (int r = 0; r < 9; ++r) acc[r] += sc[r * 1024 + k] * w;
            }
#pragma unroll
            for (int r = 0; r < 9; ++r) part[(wave * 9 + r) * 64 + lane] = acc[r];
            __syncthreads();
            for (int i = tid; i < 9 * 64; i += NTHR) {
                const int r = i >> 6, cl = i & 63; float s = 0.f;
#pragma unroll
                for (int w = 0; w < 8; ++w) s += part[(w * 9 + r) * 64 + cl];
                MOD[r * 6144 + it * 64 + cl] = s + bada[it * 64 + cl];
            }
            __syncthreads();
        }
    }
    SEAM(0);

    if (IN(1)) {
        const float* ctxp = args.in[I_CTX]; const float* wn = args.in[I_NPM];
        for (int row = gw; row < TT; row += NGW) {
            const float* src = row < T ? x + (size_t)row * D : ctxp + (size_t)(row - T) * D;
            const int b = row < T ? row / SEQ : 8;
            const float* md = MOD + b * 6144;
            f32x4 v[4]; float ss = 0.f;
#pragma unroll
            for (int j = 0; j < 4; ++j) { v[j] = *(const f32x4*)(src + j * 256 + lane * 4); ss += v[j].x * v[j].x + v[j].y * v[j].y + v[j].z * v[j].z + v[j].w * v[j].w; }
            const float rstd = rsqrtf(wave_sum(ss) * (1.f / D) + EPS);
#pragma unroll
            for (int j = 0; j < 4; ++j) {
                const int cb = j * 256 + lane * 4;
#pragma unroll
                for (int e = 0; e < 4; ++e) { const int cc = cb + e; const float t = v[j][e] * rstd * wn[cc]; H[(size_t)row * D + cc] = f2bf(t * (1.f + md[1024 + cc]) + md[cc]); }
            }
        }
    }
    SEAM(1);

    if (IN(2)) {
        const float* win = args.in[I_WIN];
        LAS float* As = (LAS float*)lds; LAS float* Bs = As + GK * GAP;
        auto af = [&](int m, int k) { return bf2f(H[(size_t)m * D + k]); };
        auto bfn = [&](int k, int n) { return win[(size_t)k * DIN + n]; };
        auto ef = [&](int m, int n, float v) {
            if (n < 256) PQK[(size_t)m * 512 + n] = f2bf(v);
            else if (n < 512) PQK[(size_t)m * 512 + n] = f2bf(v * 0.125f);
            else if (n < 1024) PV[(size_t)m * 512 + n - 512] = f2bf(v);
            else if (n < 1536) PO[(size_t)m * 512 + n - 1024] = f2bf(v);
            else if (n < 1552) GATES[(size_t)m * 32 + n - 1536] = v;
            else if (n < 3088) RAW[(size_t)m * 1536 + n - 1552] = f2bf(v);
            else if (n < 3600) PZ[(size_t)m * 512 + n - 3088] = f2bf(v);
            else GATES[(size_t)m * 32 + 16 + n - 3600] = v;
        };
        constexpr int NMT = TT / GT, NNT = (DIN + GT - 1) / GT;
        for (int it = bid; it < NMT * NNT; it += G) { const int mt = it / NNT, nt = it % NNT; ngemm_tile(mt * GT, nt * GT, TT, DIN, D, af, bfn, ef, As, Bs); }
    }
    SEAM(2);

    if (IN(3)) {
        const float* cw = args.in[I_GDCW];
        for (long item = gw; item < (long)TT * 12; item += NGW) {
            const int row = (int)(item / 12), seg = (int)(item % 12);
            int nb[5];
            if (row < T) { const int b = row / SEQ, p = row % SEQ, j = (p % GW_) * ROWS + p / GW_;
#pragma unroll
                for (int w = 0; w < 5; ++w) { const int jj = j + w - 2; nb[w] = (jj >= 0 && jj < SEQ) ? b * SEQ + (jj % ROWS) * GW_ + jj / ROWS : -1; } }
            else { const int q = row - T, b = q / CTXL, p = q % CTXL;
#pragma unroll
                for (int w = 0; w < 5; ++w) { const int jj = p + w - 2; nb[w] = (jj >= 0 && jj < CTXL) ? T + b * CTXL + jj : -1; } }
            const int c0 = seg * 128 + lane * 2;
            float a0 = 0.f, a1 = 0.f;
#pragma unroll
            for (int w = 0; w < 5; ++w) if (nb[w] >= 0) { const unsigned u = *(const unsigned*)(RAW + (size_t)nb[w] * 1536 + c0);
                a0 += bf2f((bf16)(u & 0xffffu)) * cw[w * 1536 + c0]; a1 += bf2f((bf16)(u >> 16)) * cw[w * 1536 + c0 + 1]; }
            a0 = siluf_(a0); a1 = siluf_(a1);
            if (seg < 8) { const float r = rsqrtf(wave_sum(a0 * a0 + a1 * a1) + EPS); a0 *= r; a1 *= r; }
            *(unsigned*)(QKVP + (size_t)row * 1536 + c0) = (unsigned)f2bf(a0) | ((unsigned)f2bf(a1) << 16);
        }
    }
    SEAM(3);

    if (IN(4)) {
        LAS float* red = (LAS float*)lds;
        LAS float* redd = red + 2 * 2 * 4 * 128;
        const int dv = tid & 127, g = tid >> 7;
        for (int it = bid; it < 128; it += G) {
            const int kind = it >> 6, sq = it & 63, b = sq >> 3, h = (sq >> 1) & 3, dir = sq & 1;
            if (kind == 0) {
                const float ib = args.in[I_MLIB][dir * 4 + h], fb = args.in[I_MLFB][dir * 4 + h];
                float C[16], n[16];
#pragma unroll
                for (int i = 0; i < 16; ++i) { C[i] = 0.f; n[i] = 0.f; }
                for (int s = 0; s < CTXL + SEQ; ++s) {
                    int row; if (s < CTXL) row = T + b * CTXL + (dir ? CTXL - 1 - s : s); else { const int li = s - CTXL; row = b * SEQ + (dir ? SEQ - 1 - li : li); }
                    const uint4 q0 = *(const uint4*)(PQK + (size_t)row * 512 + h * 64 + g * 16), q1 = *(const uint4*)(PQK + (size_t)row * 512 + h * 64 + g * 16 + 8);
                    const uint4 k0 = *(const uint4*)(PQK + (size_t)row * 512 + 256 + h * 64 + g * 16), k1 = *(const uint4*)(PQK + (size_t)row * 512 + 256 + h * 64 + g * 16 + 8);
                    const float v = bf2f(PV[(size_t)row * 512 + h * 128 + dv]);
                    const float ip = GATES[(size_t)row * 32 + dir * 8 + h] + ib, fp = GATES[(size_t)row * 32 + dir * 8 + 4 + h] + fb;
                    const float fw = sigmoidf_(fp), iw = __expf(ip);
                    const unsigned qu[8] = {q0.x, q0.y, q0.z, q0.w, q1.x, q1.y, q1.z, q1.w}, ku[8] = {k0.x, k0.y, k0.z, k0.w, k1.x, k1.y, k1.z, k1.w};
                    float pn = 0.f, pd = 0.f;
#pragma unroll
                    for (int i = 0; i < 16; ++i) {
                        const float qv = bf2f((bf16)((i & 1) ? (qu[i >> 1] >> 16) : (qu[i >> 1] & 0xffffu)));
                        const float kv = bf2f((bf16)((i & 1) ? (ku[i >> 1] >> 16) : (ku[i >> 1] & 0xffffu)));
                        C[i] = fw * C[i] + iw * kv * v; n[i] = fw * n[i] + iw * kv;
                        pn += C[i] * qv; pd += n[i] * qv;
                    }
                    const int par = s & 1;
                    red[(par * 2 + 0) * 512 + g * 128 + dv] = pn;
                    if (dv == 0) redd[par * 4 + g] = pd;
                    __syncthreads();
                    if (g == 0 && s >= CTXL) {
                        const float num = red[(par * 2) * 512 + dv] + red[(par * 2) * 512 + 128 + dv] + red[(par * 2) * 512 + 256 + dv] + red[(par * 2) * 512 + 384 + dv];
                        const float den = redd[par * 4] + redd[par * 4 + 1] + redd[par * 4 + 2] + redd[par * 4 + 3];
                        HML[((size_t)dir * T + row) * 512 + h * 128 + dv] = f2bf(num / fmaxf(fabsf(den), 1.f));
                    }
                }
                __syncthreads();
            } else {
                const float aexp = __expf(args.in[I_GDAL][dir * 4 + h]), dtb = args.in[I_GDDT][dir * 4 + h];
                float S[32];
#pragma unroll
                for (int i = 0; i < 32; ++i) S[i] = 0.f;
                for (int s = 0; s < CTXL + SEQ; ++s) {
                    int row; if (s < CTXL) row = T + b * CTXL + (dir ? CTXL - 1 - s : s); else { const int li = s - CTXL; const int j = dir ? SEQ - 1 - li : li; row = b * SEQ + (j % ROWS) * GW_ + j / ROWS; }
                    const bf16* qp = QKVP + (size_t)row * 1536 + h * 128 + g * 32; const bf16* kp = qp + 512;
                    uint4 qq[4], kk[4];
#pragma unroll
                    for (int i = 0; i < 4; ++i) { qq[i] = *(const uint4*)(qp + i * 8); kk[i] = *(const uint4*)(kp + i * 8); }
                    const float v = bf2f(QKVP[(size_t)row * 1536 + 1024 + h * 128 + dv]);
                    const float ga = GATES[(size_t)row * 32 + 16 + dir * 8 + h], gb = GATES[(size_t)row * 32 + 16 + dir * 8 + 4 + h];
                    const float eg = __expf(-aexp * softplusf_(ga + dtb)), beta = sigmoidf_(gb);
                    float qf[32], kf[32];
#pragma unroll
                    for (int i = 0; i < 4; ++i) { const unsigned qu[4] = {qq[i].x, qq[i].y, qq[i].z, qq[i].w}, ku[4] = {kk[i].x, kk[i].y, kk[i].z, kk[i].w};
#pragma unroll
                        for (int e = 0; e < 4; ++e) { qf[i * 8 + 2 * e] = bf2f((bf16)(qu[e] & 0xffffu)); qf[i * 8 + 2 * e + 1] = bf2f((bf16)(qu[e] >> 16));
                            kf[i * 8 + 2 * e] = bf2f((bf16)(ku[e] & 0xffffu)); kf[i * 8 + 2 * e + 1] = bf2f((bf16)(ku[e] >> 16)); } }
                    const int par = s & 1;
                    float pk = 0.f;
#pragma unroll
                    for (int i = 0; i < 32; ++i) { S[i] *= eg; pk += kf[i] * S[i]; }
                    red[(par * 2 + 0) * 512 + g * 128 + dv] = pk;
                    __syncthreads();
                    const float kS = red[(par * 2) * 512 + dv] + red[(par * 2) * 512 + 128 + dv] + red[(par * 2) * 512 + 256 + dv] + red[(par * 2) * 512 + 384 + dv];
                    const float delta = beta * (v - kS);
                    float po = 0.f;
#pragma unroll
                    for (int i = 0; i < 32; ++i) { S[i] += kf[i] * delta; po += qf[i] * S[i]; }
                    red[(par * 2 + 1) * 512 + g * 128 + dv] = po;
                    __syncthreads();
                    if (g == 0 && s >= CTXL) {
                        const float o = red[(par * 2 + 1) * 512 + dv] + red[(par * 2 + 1) * 512 + 128 + dv] + red[(par * 2 + 1) * 512 + 256 + dv] + red[(par * 2 + 1) * 512 + 384 + dv];
                        OGD[((size_t)dir * T + row) * 512 + h * 128 + dv] = f2bf(o * 0.08838834764831845f);
                    }
                }
                __syncthreads();
            }
        }
    }
    SEAM(4);

    if (IN(5)) {
        const float* mlnw = args.in[I_MLNW]; const float* gdnw = args.in[I_GDNW];
        for (long item = gw; item < (long)T * 8; item += NGW) {
            const int t = (int)(item >> 3), sl = (int)(item & 7), c0 = lane * 2;
            float a0, a1, g0, g1;
            if (sl < 4) {
                const unsigned u0 = *(const unsigned*)(HML + (size_t)t * 512 + sl * 128 + c0), u1 = *(const unsigned*)(HML + ((size_t)T + t) * 512 + sl * 128 + c0);
                const unsigned uo = *(const unsigned*)(PO + (size_t)t * 512 + sl * 128 + c0);
                a0 = bf2f((bf16)(u0 & 0xffffu)) + bf2f((bf16)(u1 & 0xffffu)); a1 = bf2f((bf16)(u0 >> 16)) + bf2f((bf16)(u1 >> 16));
                g0 = mlnw[sl * 128 + c0] * sigmoidf_(bf2f((bf16)(uo & 0xffffu))); g1 = mlnw[sl * 128 + c0 + 1] * sigmoidf_(bf2f((bf16)(uo >> 16)));
            } else {
                const int hh = sl - 4;
                const unsigned u0 = *(const unsigned*)(OGD + (size_t)t * 512 + hh * 128 + c0), u1 = *(const unsigned*)(OGD + ((size_t)T + t) * 512 + hh * 128 + c0);
                const unsigned uz = *(const unsigned*)(PZ + (size_t)t * 512 + hh * 128 + c0);
                a0 = bf2f((bf16)(u0 & 0xffffu)) + bf2f((bf16)(u1 & 0xffffu)); a1 = bf2f((bf16)(u0 >> 16)) + bf2f((bf16)(u1 >> 16));
                g0 = gdnw[c0] * siluf_(bf2f((bf16)(uz & 0xffffu))); g1 = gdnw[c0 + 1] * siluf_(bf2f((bf16)(uz >> 16)));
            }
            const float r = rsqrtf(wave_sum(a0 * a0 + a1 * a1) * (1.f / 128.f) + EPS);
            *(unsigned*)(YMIX + (size_t)t * D + sl * 128 + c0) = (unsigned)f2bf(a0 * r * g0) | ((unsigned)f2bf(a1 * r * g1) << 16);
        }
    }
    SEAM(5);

    if (IN(6)) {
        const float* wout = args.in[I_WOUT];
        LAS float* As = (LAS float*)lds; LAS float* Bs = As + GK * GAP;
        auto af = [&](int m, int k) { return bf2f(YMIX[(size_t)m * D + k]); };
        auto bfn = [&](int k, int n) { return wout[(size_t)k * D + n]; };
        auto ef = [&](int m, int n, float v) { YLAT[(size_t)m * D + n] = f2bf(v); };
        for (int it = bid; it < (T / GT) * (D / GT); it += G) { const int mt = it / (D / GT), nt = it % (D / GT); ngemm_tile(mt * GT, nt * GT, T, D, D, af, bfn, ef, As, Bs); }
    }
    SEAM(6);

    if (IN(7)) {
        const float* wq = args.in[I_NQM]; const float* wf = args.in[I_NPF];
        for (int row = gw; row < T; row += NGW) {
            const float* md = MOD + (row / SEQ) * 6144;
            float yv[16], xv[16]; float ss = 0.f;
#pragma unroll
            for (int j = 0; j < 4; ++j) { const uint2 u = *(const uint2*)(YLAT + (size_t)row * D + j * 256 + lane * 4);
                yv[j * 4] = bf2f((bf16)(u.x & 0xffffu)); yv[j * 4 + 1] = bf2f((bf16)(u.x >> 16)); yv[j * 4 + 2] = bf2f((bf16)(u.y & 0xffffu)); yv[j * 4 + 3] = bf2f((bf16)(u.y >> 16)); }
#pragma unroll
            for (int i = 0; i < 16; ++i) ss += yv[i] * yv[i];
            const float r1 = rsqrtf(wave_sum(ss) * (1.f / D) + EPS);
            float s2 = 0.f;
#pragma unroll
            for (int j = 0; j < 4; ++j) { const f32x4 xx = *(const f32x4*)(x + (size_t)row * D + j * 256 + lane * 4);
#pragma unroll
                for (int e = 0; e < 4; ++e) { const int cc = j * 256 + lane * 4 + e; const float v = xx[e] + md[2048 + cc] * (yv[j * 4 + e] * r1 * wq[cc]); xv[j * 4 + e] = v; s2 += v * v; } }
            const float r2 = rsqrtf(wave_sum(s2) * (1.f / D) + EPS);
#pragma unroll
            for (int j = 0; j < 4; ++j) { f32x4 o, hf;
#pragma unroll
                for (int e = 0; e < 4; ++e) { const int cc = j * 256 + lane * 4 + e; o[e] = xv[j * 4 + e]; hf[e] = xv[j * 4 + e] * r2 * wf[cc] * (1.f + md[4096 + cc]) + md[3072 + cc]; }
                *(f32x4*)(out + (size_t)row * D + j * 256 + lane * 4) = o; *(f32x4*)(HF32 + (size_t)row * D + j * 256 + lane * 4) = hf; }
        }
    }
    SEAM(7);

    if (IN(8)) {
        const float* rw = args.in[I_RW];
        LAS float* As = (LAS float*)lds; LAS float* Bs = As + GK * GAP;
        auto af = [&](int m, int k) { return HF32[(size_t)m * D + k]; };
        auto bfn = [&](int k, int n) { return rw[(size_t)k * NE + n]; };
        auto ef = [&](int m, int n, float v) { LOG[(size_t)m * NE + n] = v; };
        for (int it = bid; it < (T / GT) * (NE / GT); it += G) { const int mt = it / (NE / GT), nt = it % (NE / GT); ngemm_tile(mt * GT, nt * GT, T, NE, D, af, bfn, ef, As, Bs); }
    }
    SEAM(8);

    if (IN(9)) {
        const float* rb = args.in[I_RB];
        LAS float* selb = (LAS float*)lds + wave * 256;
        for (int t = gw; t < T; t += NGW) {
            const f32x4 lg = *(const f32x4*)(LOG + (size_t)t * NE + lane * 4);
            float sc[4], sel[4];
#pragma unroll
            for (int e = 0; e < 4; ++e) { sc[e] = sigmoidf_(lg[e]); sel[e] = sc[e] + rb[lane * 4 + e]; selb[lane * 4 + e] = sel[e]; }
            asm volatile("s_waitcnt lgkmcnt(0)" ::: "memory");
            float gs = -INFINITY;
            if (lane < 8) { float m1 = -INFINITY, m2 = -INFINITY;
                for (int i = 0; i < 32; ++i) { const float v = selb[lane * 32 + i]; if (v > m1) { m2 = m1; m1 = v; } else if (v > m2) m2 = v; }
                gs = m1 + m2; }
            int rank = 0; const int myg = lane >> 3;
            const float mygs = __shfl(gs, myg);
#pragma unroll
            for (int j = 0; j < 8; ++j) { const float o = __shfl(gs, j); rank += (o > mygs || (o == mygs && j < myg)) ? 1 : 0; }
            const bool gsel = rank < 4;
#pragma unroll
            for (int e = 0; e < 4; ++e) if (!gsel) sel[e] = -INFINITY;
            float gsum = 0.f; float myw = 0.f; int myi = 0;
#pragma unroll
            for (int r = 0; r < 8; ++r) {
                float bv = sel[0]; int bi = lane * 4; float bs = sc[0];
#pragma unroll
                for (int e = 1; e < 4; ++e) if (sel[e] > bv) { bv = sel[e]; bi = lane * 4 + e; bs = sc[e]; }
#pragma unroll
                for (int o = 1; o < 64; o <<= 1) { const float ov = __shfl_xor(bv, o); const int oi = __shfl_xor(bi, o); const float os = __shfl_xor(bs, o);
                    if (ov > bv || (ov == bv && oi < bi)) { bv = ov; bi = oi; bs = os; } }
                gsum += bs; if (lane == r) { myw = bs; myi = bi; }
#pragma unroll
                for (int e = 0; e < 4; ++e) if (bi == lane * 4 + e) sel[e] = -INFINITY;
            }
            if (lane < 8) { IDX[(size_t)t * 8 + lane] = myi; GWT[(size_t)t * 8 + lane] = myw / gsum * 2.5f; atomicAdd(&ctl[CW_CNT + myi], 1u); }
        }
    }
    SEAM(9);

    if (IN(10)) {
        if (bid == 0 && tid == 0) {
            unsigned off = 0; int nrt = 0;
            for (int e = 0; e < NE; ++e) { const unsigned c = ctl[CW_CNT + e]; ctl[CW_OFF + e] = off;
                for (unsigned s = 0; s < c; s += GT) { RT[nrt] = e; RT[8192 + nrt] = (int)(off + s); RT[16384 + nrt] = (int)((c - s) < (unsigned)GT ? (c - s) : (unsigned)GT); ++nrt; }
                off += c; }
            ctl[CW_OFF + NE] = off; ctl[CW_NRT] = (unsigned)nrt;
        }
    }
    SEAM(10);

    if (IN(11)) {
        for (long i = (long)bid * NTHR + tid; i < (long)T * 8; i += (long)G * NTHR) {
            const int e = IDX[i]; const unsigned pos = ctl[CW_OFF + e] + atomicAdd(&ctl[CW_FILL + e], 1u);
            LTOK[pos] = (int)(i >> 3); LW[pos] = GWT[i];
        }
    }
    SEAM(11);

    if (IN(12)) {
        LAS float* As = (LAS float*)lds; LAS float* Bs = As + GK * GAP;
        const float* wsg = args.in[I_WSG]; const float* wsu = args.in[I_WSU]; const float* wg = args.in[I_WG]; const float* wu = args.in[I_WU];
        const int nrt = (int)ctl[CW_NRT];
        const int nshared = (T / GT) * 4, ntot = nshared + nrt * 4;
        for (int it = bid; it < ntot; it += G) {
            if (it < nshared) {
                const int mt = it >> 2, nt = it & 3;
                auto af = [&](int m, int k) { return HF32[(size_t)m * D + k]; };
                auto bfn = [&](int k, int n) { return n < 256 ? wsg[(size_t)k * 256 + n] : wsu[(size_t)k * 256 + n - 256]; };
                auto ef = [&](int m, int n, float v) { GUS[(size_t)m * 512 + n] = f2bf(v); };
                ngemm_tile(mt * GT, nt * GT, T, 512, D, af, bfn, ef, As, Bs);
            } else {
                const int r = (it - nshared) >> 2, nt = (it - nshared) & 3;
                const int e = RT[r], st = RT[8192 + r], nr = RT[16384 + r];
                const float* wge = wg + (size_t)e * D * DE; const float* wue = wu + (size_t)e * D * DE;
                auto af = [&](int m, int k) { return HF32[(size_t)LTOK[st + m] * D + k]; };
                auto bfn = [&](int k, int n) { return n < 256 ? wge[(size_t)k * 256 + n] : wue[(size_t)k * 256 + n - 256]; };
                auto ef = [&](int m, int n, float v) { GU[(size_t)(st + m) * 512 + n] = f2bf(v); };
                ngemm_tile(0, nt * GT, nr, 512, D, af, bfn, ef, As, Bs);
            }
        }
    }
    SEAM(12);

    if (IN(13)) {
        LAS float* As = (LAS float*)lds; LAS float* Bs = As + GK * GAP;
        const float* wsd = args.in[I_WSD];
        auto af = [&](int m, int k) { return siluf_(bf2f(GUS[(size_t)m * 512 + k])) * bf2f(GUS[(size_t)m * 512 + 256 + k]); };
        auto bfn = [&](int k, int n) { return wsd[(size_t)k * D + n]; };
        auto ef = [&](int m, int n, float v) { Y[(size_t)m * D + n] = v; };
        for (int it = bid; it < (T / GT) * (D / GT); it += G) { const int mt = it / (D / GT), nt = it % (D / GT); ngemm_tile(mt * GT, nt * GT, T, D, DE, af, bfn, ef, As, Bs); }
    }
    SEAM(13);

    if (IN(14)) {
        LAS float* As = (LAS float*)lds; LAS float* Bs = As + GK * GAP;
        const float* wd = args.in[I_WD];
        const int nrt = (int)ctl[CW_NRT];
        for (int it = bid; it < nrt * 8; it += G) {
            const int r = it >> 3, nt = it & 7;
            const int e = RT[r], st = RT[8192 + r], nr = RT[16384 + r];
            const float* wde = wd + (size_t)e * DE * D;
            auto af = [&](int m, int k) { return siluf_(bf2f(GU[(size_t)(st + m) * 512 + k])) * bf2f(GU[(size_t)(st + m) * 512 + 256 + k]); };
            auto bfn = [&](int k, int n) { return wde[(size_t)k * D + n]; };
            auto ef = [&](int m, int n, float v) { atomicAdd(&Y[(size_t)LTOK[st + m] * D + n], LW[st + m] * v); };
            ngemm_tile(0, nt * GT, nr, D, DE, af, bfn, ef, As, Bs);
        }
    }
    SEAM(14);

    if (IN(15)) {
        const float* wq = args.in[I_NQF];
        for (int row = gw; row < T; row += NGW) {
            const float* md = MOD + (row / SEQ) * 6144;
            f32x4 yv[4]; float ss = 0.f;
#pragma unroll
            for (int j = 0; j < 4; ++j) { yv[j] = *(const f32x4*)(Y + (size_t)row * D + j * 256 + lane * 4); ss += yv[j].x * yv[j].x + yv[j].y * yv[j].y + yv[j].z * yv[j].z + yv[j].w * yv[j].w; }
            const float r1 = rsqrtf(wave_sum(ss) * (1.f / D) + EPS);
#pragma unroll
            for (int j = 0; j < 4; ++j) { f32x4 xx = *(const f32x4*)(out + (size_t)row * D + j * 256 + lane * 4);
#pragma unroll
                for (int e = 0; e < 4; ++e) { const int cc = j * 256 + lane * 4 + e; xx[e] += md[5120 + cc] * (yv[j][e] * r1 * wq[cc]); }
                *(f32x4*)(out + (size_t)row * D + j * 256 + lane * 4) = xx; }
        }
    }
#undef IN
#undef SEAM
}

constexpr int LDS_BYTES = 147456;
extern "C" void kernel_launch(void* const* d_in, const int* in_sizes, int n_in, void* d_out, int out_size, void* d_ws, size_t ws_size, hipStream_t stream) {
    static int grid = 0;
    if (grid == 0) {
        if (n_in != 27 || out_size != T * D || ws_size < WS_END) { fprintf(stderr, "kernel_launch: unexpected shapes n_in %d out %d ws %zu (need %zu)\n", n_in, out_size, ws_size, (size_t)WS_END); grid = -1; return; }
        int dev = 0, cus = 0, per_cu = 0;
        if (hipGetDevice(&dev) != hipSuccess || hipDeviceGetAttribute(&cus, hipDeviceAttributeMultiprocessorCount, dev) != hipSuccess) { grid = -1; return; }
        if (hipFuncSetAttribute((const void*)fwd, hipFuncAttributeMaxDynamicSharedMemorySize, LDS_BYTES) != hipSuccess) { fprintf(stderr, "kernel_launch: hipFuncSetAttribute failed\n"); grid = -1; return; }
        if (hipOccupancyMaxActiveBlocksPerMultiprocessor(&per_cu, (const void*)fwd, NTHR, LDS_BYTES) != hipSuccess || per_cu < 1) fprintf(stderr, "kernel_launch: occupancy query says %d\n", per_cu);
        (void)hipGetLastError();
        grid = cus;
    }
    if (grid < 0) return;
    (void)hipMemsetAsync((char*)d_ws + WS_CTL, 0, CTL_ZERO_BYTES, stream);
    Args a{};
    for (int i = 0; i < 27; ++i) a.in[i] = (const float*)d_in[i];
    a.out = (float*)d_out; a.ws = (unsigned char*)d_ws;
    if (N_LAUNCH_MODE == 1) { a.ph_lo = 0; a.ph_hi = NPHASE; hipLaunchKernelGGL(fwd, dim3(grid), dim3(NTHR), LDS_BYTES, stream, a); }
    else for (int p = 0; p < NPHASE; ++p) { a.ph_lo = p; a.ph_hi = p + 1; hipLaunchKernelGGL(fwd, dim3(grid), dim3(NTHR), LDS_BYTES, stream, a); }
}
```

```cpp
#include <hip/hip_runtime.h>
#include <cstdio>
#include <cstdint>

#ifndef N_LAUNCH_MODE
#define N_LAUNCH_MODE 1
#endif

#ifndef ROUTER_LO
#define ROUTER_LO 1
#endif
#ifndef SCAN_DBL
#define SCAN_DBL 0
#endif
#ifndef REP_GEMM
#define REP_GEMM (-1)
#endif
#ifndef REP_PHASE
#define REP_PHASE (-1)
#define REP_N 1
#endif
#define LAS __attribute__((address_space(3)))
typedef unsigned short bf16;
typedef float f32x4 __attribute__((ext_vector_type(4)));

constexpr int NB = 8, SEQ = 8192, D = 1024, CTXL = 256, GW_ = 64, ROWS = SEQ / GW_;
constexpr int T = NB * SEQ, TC = NB * CTXL, TT = T + TC;
constexpr int DIN = 3616;
constexpr int NE = 256, TOPK = 8, NGRP = 8, DE = 256;
constexpr float EPS = 1e-6f;
constexpr int NTHR = 512, NWAVE = 8;
constexpr int NPHASE = 15;

constexpr size_t MiB = 1u << 20;
constexpr size_t WS_CTL = 0, CTL_ZERO_BYTES = 1 * MiB;
constexpr size_t WS_MOD = 1 * MiB;
constexpr size_t WS_WCNT = 1 * MiB + 512 * 1024;
constexpr size_t WS_IDX = 2 * MiB;
constexpr size_t WS_GWT = 4 * MiB;
constexpr size_t WS_LTOK = 6 * MiB;
constexpr size_t WS_LW = 9 * MiB;
constexpr size_t WS_TE = 12 * MiB;
constexpr size_t WS_LDST = 23 * MiB;
constexpr size_t WS_GATES = 14 * MiB;
constexpr size_t WS_WINT = 23 * MiB;
constexpr size_t WS_WOUTT = 31 * MiB;
constexpr size_t WS_WSGU8 = 33 * MiB;
constexpr size_t WS_WSD8 = 34 * MiB;
constexpr size_t WS_A = 35 * MiB;
constexpr size_t WS_H = WS_A, WS_PQK = WS_A + 132 * MiB, WS_PV = WS_PQK + 66 * MiB, WS_PO = WS_PV + 66 * MiB;
constexpr size_t WS_RAW = WS_PO + 66 * MiB, WS_PZ = WS_RAW + 198 * MiB, WS_QKVP = WS_PZ + 66 * MiB;
constexpr size_t WS_HML = WS_PQK, WS_OGD = WS_RAW, WS_YMIX = WS_H, WS_YLAT = WS_QKVP;
constexpr size_t WS_MQ = WS_H, WS_MKT = WS_H + 33 * MiB, WS_MQK = WS_H + 66 * MiB, WS_MSC = WS_H + 99 * MiB;
constexpr size_t WS_GQ = WS_QKVP, WS_GKT = WS_GQ + 66 * MiB, WS_GVT = WS_GKT + 66 * MiB, WS_GQK = WS_GVT + 66 * MiB;
constexpr size_t WS_GT = WS_GQK + 33 * MiB, WS_GSC = WS_GT + 66 * MiB, WS_MVT = WS_GSC + 9 * MiB;
constexpr size_t WS_RWT = 13 * MiB;
constexpr size_t WS_WD8 = 1001 * MiB;
constexpr size_t WS_WGU8 = 821 * MiB;
constexpr size_t WS_HF8 = 757 * MiB;
constexpr size_t WS_HFFN = WS_YLAT;
constexpr size_t WS_LOGH = WS_PO, WS_LOGL = WS_PZ;
constexpr size_t WS_CONTRIB = 327 * MiB;
constexpr size_t WS_HB8 = 163 * MiB;
constexpr size_t WS_HBS8 = 311 * MiB;
constexpr size_t WS_X1B = 35 * MiB;
constexpr size_t WS_END = 1067 * MiB;
constexpr int CAPROWS = T * 8 + 320 * 256;
constexpr size_t WS_LDST_UNUSED = 0;

constexpr int CW_BAR = 4096;
constexpr int CW_CNT = 16384;
constexpr int CW_FILL = 16384 + 512;
constexpr int CW_OFF = 16384 + 1024;
constexpr int CW_CQA = 16384 + 3072, CW_CQB = 16384 + 3104;
constexpr int NCQA = 8192, NCQB = 4096;
constexpr int CW_NRT = 16384 + 2048;

__device__ __forceinline__ float bf2f(bf16 v) { return __uint_as_float(((unsigned)v) << 16); }
__device__ __forceinline__ bf16 f2bf(float f) { unsigned u = __float_as_uint(f); u += 0x7fffu + ((u >> 16) & 1u); return (bf16)(u >> 16); }
__device__ __forceinline__ float sigmoidf_(float x) { return __builtin_amdgcn_rcpf(1.0f + __expf(-x)); }
__device__ __forceinline__ float siluf_(float x) { return x * __builtin_amdgcn_rcpf(1.0f + __expf(-x)); }
__device__ __forceinline__ float softplusf_(float x) { return x > 20.f ? x : log1pf(__expf(x)); }
template <int CTRL> __device__ __forceinline__ float dpp_f(float v) { return __builtin_bit_cast(float, __builtin_amdgcn_update_dpp(0, __builtin_bit_cast(int, v), CTRL, 0xf, 0xf, false)); }
__device__ __forceinline__ float readlane_f(float v, int l) { return __builtin_bit_cast(float, __builtin_amdgcn_readlane(__builtin_bit_cast(int, v), l)); }
__device__ __forceinline__ float wave_max_all(float v) {
    v = fmaxf(v, dpp_f<0xB1>(v)); v = fmaxf(v, dpp_f<0x4E>(v)); v = fmaxf(v, dpp_f<0x141>(v)); v = fmaxf(v, dpp_f<0x140>(v));
    return fmaxf(fmaxf(readlane_f(v, 0), readlane_f(v, 16)), fmaxf(readlane_f(v, 32), readlane_f(v, 48)));
}
__device__ __forceinline__ int opaque(int x) { asm volatile("" : "+v"(x)); return x; }
__device__ __forceinline__ float wave_sum(float v) {
    v += dpp_f<0xB1>(v); v += dpp_f<0x4E>(v); v += dpp_f<0x141>(v); v += dpp_f<0x140>(v);
    v = (readlane_f(v, 0) + readlane_f(v, 16)) + (readlane_f(v, 32) + readlane_f(v, 48));
    return v;
}

#define XB_TMO      128
#define XB_XCNT(j)  (256  + 64 * (j))
#define XB_XSUB(j)  (1280 + 64 * (j))
#define XB_XGEN(j)  (2304 + 64 * (j))
#define XB_TOP      3328
#define XB_TOPGEN   3392
#define XCD_BAR_WORDS 3456
#define XB_SPIN_CAP (1u << 18)
__device__ __forceinline__ unsigned xb_ld(unsigned* p)              { return __hip_atomic_load(p, __ATOMIC_RELAXED, __HIP_MEMORY_SCOPE_AGENT); }
__device__ __forceinline__ unsigned xb_add(unsigned* p, unsigned v) { return __hip_atomic_fetch_add(p, v, __ATOMIC_RELAXED, __HIP_MEMORY_SCOPE_AGENT); }
__device__ __forceinline__ unsigned xb_xcc_id() { return (unsigned)__builtin_amdgcn_s_getreg((3 << 11) | 20) & 0xFu; }
#define XB_SPIN(cond, bar) do { unsigned _sp = 0; while (cond) { __builtin_amdgcn_s_sleep(1); \
    if ((++_sp & 255u) == 0u) { if (xb_ld(&(bar)[XB_TMO])) break; if (_sp > XB_SPIN_CAP) { atomicAdd(&(bar)[XB_TMO], 1u); break; } } } } while (0)
struct XcdBarrier { unsigned* bar; unsigned x; volatile LAS unsigned* st; };
__device__ __forceinline__ XcdBarrier xcd_barrier_post(unsigned* bar, volatile LAS unsigned* st) {
    XcdBarrier b; b.bar = bar; b.x = xb_xcc_id(); b.st = st;
    if (threadIdx.x == 0) (void)xb_add(&bar[XB_XCNT(b.x)], 1u);
    return b;
}
__device__ __forceinline__ void xcd_barrier_complete(unsigned* bar, unsigned x, unsigned& nloc, unsigned& nx) {
    const unsigned G = gridDim.x * gridDim.y * gridDim.z;
    unsigned sum, cnt, mine, sp = 0u;
    for (;;) {
        sum = 0u; cnt = 0u; mine = 0u;
#pragma unroll
        for (unsigned j = 0; j < 16; ++j) { const unsigned c = xb_ld(&bar[XB_XCNT(j)]); sum += c; cnt += (c > 0u) ? 1u : 0u; mine = (j == x) ? c : mine; }
        if (sum == G) break;
        __builtin_amdgcn_s_sleep(1);
        if ((++sp & 255u) == 0u) { if (xb_ld(&bar[XB_TMO])) break; if (sp > XB_SPIN_CAP) { atomicAdd(&bar[XB_TMO], 1u); break; } }
    }
    nloc = mine > 0u ? mine : 1u; nx = cnt > 0u ? cnt : 1u;
}
__device__ __forceinline__ void xcd_barrier(const XcdBarrier& b) {
    asm volatile("s_waitcnt vmcnt(0)" ::: "memory");
    __syncthreads();
    if (threadIdx.x == 0) {
        unsigned* bar = b.bar;
        __builtin_amdgcn_s_waitcnt(0);
        unsigned nloc = b.st[0], nx = b.st[1];
        if (nloc == 0u) { xcd_barrier_complete(bar, b.x, nloc, nx); b.st[0] = nloc; b.st[1] = nx; }
        const unsigned old = xb_add(&bar[XB_XSUB(b.x)], 1u);
        const unsigned gen = old / nloc;
        if (old + 1u == (gen + 1u) * nloc) {
            __builtin_amdgcn_fence(__ATOMIC_RELEASE, "agent");
            asm volatile("s_waitcnt vmcnt(0)" ::: "memory");
            const unsigned og = xb_add(&bar[XB_TOP], 1u);
            const unsigned tg = og / nx;
            if (og + 1u == (tg + 1u) * nx) xb_add(&bar[XB_TOPGEN], 1u);
            else XB_SPIN(xb_ld(&bar[XB_TOPGEN]) == tg, bar);
            __builtin_amdgcn_fence(__ATOMIC_ACQUIRE, "agent");
            xb_add(&bar[XB_XGEN(b.x)], 1u);
            asm volatile("s_waitcnt vmcnt(0)" ::: "memory");
        } else {
            XB_SPIN(xb_ld(&bar[XB_XGEN(b.x)]) == gen, bar);
            __builtin_amdgcn_fence(__ATOMIC_ACQUIRE, "agent");
            asm volatile("s_waitcnt vmcnt(0)" ::: "memory");
        }
    }
    __syncthreads();
}

struct Args { const float* in[27]; float* out; unsigned char* ws; int ph_lo, ph_hi; };
enum { I_X = 0, I_C, I_CTX, I_CCTX, I_WADA, I_BADA, I_NPM, I_NQM, I_NPF, I_NQF, I_WIN, I_MLIB, I_MLFB, I_MLNW, I_GDCW, I_GDAL, I_GDDT, I_GDNW,
       I_WOUT, I_RW, I_RB, I_WG, I_WU, I_WD, I_WSG, I_WSU, I_WSD };

constexpr int GT = 128, GK = 16, GAP = GT + 4;
template <class AF, class BF, class EF>
__device__ __forceinline__ void ngemm_tile(int m0, int n0, int Mlim, int N, int K, const AF& af, const BF& bf, const EF& ef, LAS float* As, LAS float* Bs) {
    const int tid = opaque((int)threadIdx.x), ty = tid >> 4, tx = tid & 15;
    float acc[4][8];
#pragma unroll
    for (int i = 0; i < 4; ++i)
#pragma unroll
        for (int j = 0; j < 8; ++j) acc[i][j] = 0.f;
    for (int k0 = 0; k0 < K; k0 += GK) {
        float av[4], bv[4];
#pragma unroll
        for (int i = 0; i < 4; ++i) { const int idx = tid + i * NTHR; const int r = idx >> 4, kk = idx & 15; av[i] = (m0 + r < Mlim) ? af(m0 + r, k0 + kk) : 0.f; }
#pragma unroll
        for (int i = 0; i < 4; ++i) { const int idx = tid + i * NTHR; const int kk = idx >> 7, c = idx & 127; bv[i] = (n0 + c < N) ? bf(k0 + kk, n0 + c) : 0.f; }
        __syncthreads();
#pragma unroll
        for (int i = 0; i < 4; ++i) { const int idx = tid + i * NTHR; const int r = idx >> 4, kk = idx & 15; As[kk * GAP + r] = av[i]; }
#pragma unroll
        for (int i = 0; i < 4; ++i) { const int idx = tid + i * NTHR; const int kk = idx >> 7, c = idx & 127; Bs[kk * GT + c] = bv[i]; }
        __syncthreads();
#pragma unroll
        for (int kk = 0; kk < GK; ++kk) {
            const f32x4 a = *(const LAS f32x4*)(As + kk * GAP + ty * 4);
            const f32x4 b0 = *(const LAS f32x4*)(Bs + kk * GT + tx * 8), b1 = *(const LAS f32x4*)(Bs + kk * GT + tx * 8 + 4);
#pragma unroll
            for (int i = 0; i < 4; ++i) {
#pragma unroll
                for (int j = 0; j < 4; ++j) { acc[i][j] += a[i] * b0[j]; acc[i][4 + j] += a[i] * b1[j]; }
            }
        }
    }
#pragma unroll
    for (int i = 0; i < 4; ++i) { const int m = m0 + ty * 4 + i; if (m < Mlim) {
#pragma unroll
        for (int j = 0; j < 8; ++j) { const int n = n0 + tx * 8 + j; if (n < N) ef(m, n, acc[i][j]); } } }
    __syncthreads();
}

namespace pg {
typedef short bf16x8 __attribute__((ext_vector_type(8)));
typedef unsigned u32x4 __attribute__((ext_vector_type(4)));
constexpr int BM = 256, BK = 64, HALF = 128, HTB = HALF * BK * 2, STAGE_BYTES = 8 * HTB;
__device__ __forceinline__ int lds_byte(int r, int c) { const int st = (r >> 4) * 2 + (c >> 5), rr = r & 15, cc = c & 31, ob = rr * 64 + cc * 2; return st * 1024 + (ob ^ (((ob >> 9) & 1) << 5)); }
__device__ __forceinline__ void stage_rc(int b, int& R, int& C) { const int st = b / 1024, sb = b % 1024, swz = sb ^ (((sb >> 9) & 1) << 5); R = (st >> 1) * 16 + swz / 64; C = (st & 1) * 32 + (swz % 64) / 2; }
__device__ __forceinline__ int perm32(int rho) { const int n = rho >> 4, i = rho & 15; return 8 * (i >> 2) + 4 * n + (i & 3); }
__device__ __forceinline__ unsigned cvt_pk_bf16(float lo, float hi) { unsigned r; asm volatile("v_cvt_pk_bf16_f32 %0, %1, %2" : "=v"(r) : "v"(lo), "v"(hi)); return r; }

typedef int i32x4 __attribute__((ext_vector_type(4)));
typedef int i32x8 __attribute__((ext_vector_type(8)));
__device__ __forceinline__ i32x8 cat8(const bf16x8& lo, const bf16x8& hi) { const i32x4 a = __builtin_bit_cast(i32x4, lo), b = __builtin_bit_cast(i32x4, hi); return __builtin_shufflevector(a, b, 0, 1, 2, 3, 4, 5, 6, 7); }
__device__ __forceinline__ void mfma_f8(f32x4& acc, const i32x8& a, const i32x8& b) { asm volatile("v_mfma_f32_16x16x128_f8f6f4 %0, %1, %2, %0" : "+v"(acc) : "v"(a), "v"(b)); }
constexpr int TE_OFF = 131072, ROWS_OFF = 141312, DW_OFF = 143360;
struct Unit { const char* A; const char* B; const int* rows; int pm, pn, aux; };

__device__ __forceinline__ int xcd_remap(int L, int n) { const int q = n / 8, r = n % 8, x = L % 8, off = L / 8; return (x < r ? x * (q + 1) : r * (q + 1) + (x - r) * q) + off; }

template <class Epi, class Sched, bool GATHER, bool FP8 = false>
__device__ __forceinline__ void gemm_phase(LAS unsigned char* lds, const int KB  , const Sched& S, const Epi& E) {
    const int tid = opaque((int)threadIdx.x), wid = __builtin_amdgcn_readfirstlane(tid >> 6), lane = tid & 63, wr = wid >> 2, wc = wid & 3, fr = lane & 15, fq = lane >> 4;
    const int nt = KB / (BK * 2);
    unsigned voffA[2], voffB[2]; int RA[2], CA[2];
#pragma unroll
    for (int i = 0; i < 2; ++i) { int R, C; stage_rc(tid * 16 + i * 8192, R, C); const int Rb = Epi::PERM ? ((R & ~31) + perm32(R & 31)) : R;
        RA[i] = R; CA[i] = C; voffA[i] = (unsigned)(R * KB + C * 2); voffB[i] = (unsigned)(Rb * KB + C * 2); }
    const size_t kstep = (size_t)(BK * 2);
    const size_t hstep = (size_t)HALF * KB;
    const unsigned ldsw = (unsigned)wid * 1024u;
    const int aoff = lds_byte(wr * 64 + fr, FP8 ? fq * 16 : fq * 8), boff = lds_byte(wc * 32 + fr, FP8 ? fq * 16 : fq * 8);

    unsigned vAc[2][2], vAn[2][2];
#define PG_SA(b, h) (((b) * 2 + (h)) * HTB)
#define PG_SB(b, h) ((4 + (b) * 2 + (h)) * HTB)
#define PG_GLDS(gp, off) __builtin_amdgcn_global_load_lds((const unsigned*)(gp), (LAS unsigned*)(lds + (off)), 16, 0, 0)
#define PG_GLDS4(gp, off) __builtin_amdgcn_global_load_lds((const unsigned*)(gp), (LAS unsigned*)(lds + (off)), 4, 0, 0)
#define PG_STAGE_B(bufoff, gbase) do { _Pragma("unroll") for (int _i = 0; _i < 2; ++_i) PG_GLDS((const char*)(gbase) + voffB[_i], (bufoff) + ldsw + _i * 8192); } while (0)
#define PG_STAGE_A(bufoff, gbase, h, NX) do { _Pragma("unroll") for (int _i = 0; _i < 2; ++_i) { \
        const unsigned _v = GATHER ? ((NX) ? vAn[h][_i] : vAc[h][_i]) : voffA[_i]; \
        PG_GLDS((const char*)(gbase) + (GATHER ? (size_t)0 : (size_t)(h) * hstep) + _v, (bufoff) + ldsw + _i * 8192); } } while (0)
#define PG_ROWS(u, vA) do { _Pragma("unroll") for (int _h = 0; _h < 2; ++_h) _Pragma("unroll") for (int _i = 0; _i < 2; ++_i) \
        vA[_h][_i] = (unsigned)((u).rows[_h * HALF + RA[_i]] * KB + CA[_i] * 2); } while (0)
#define PG_LD8(p) __builtin_shufflevector(((const LAS i32x4*)(p))[0], ((const LAS i32x4*)(p))[1], 0, 1, 2, 3, 4, 5, 6, 7)
#define PG_LDA(dst, b, h) do { if constexpr (FP8) { _Pragma("unroll") for (int m = 0; m < 4; ++m) dst##8[m] = PG_LD8(lds + PG_SA(b, h) + aoff + m * 2048); } \
        else { _Pragma("unroll") for (int m = 0; m < 4; ++m) _Pragma("unroll") for (int k = 0; k < 2; ++k) dst[m][k] = *(const LAS bf16x8*)(lds + PG_SA(b, h) + aoff + m * 2048 + k * 1024); } } while (0)
#define PG_LDB(dst, b, h) do { if constexpr (FP8) { _Pragma("unroll") for (int n = 0; n < 2; ++n) dst##8[n] = PG_LD8(lds + PG_SB(b, h) + boff + n * 2048); } \
        else { _Pragma("unroll") for (int n = 0; n < 2; ++n) _Pragma("unroll") for (int k = 0; k < 2; ++k) dst[n][k] = *(const LAS bf16x8*)(lds + PG_SB(b, h) + boff + n * 2048 + k * 1024); } } while (0)
#define PG_MMA(ai, bj, At, Bt) do { __builtin_amdgcn_s_setprio(1); _Pragma("unroll") for (int m = 0; m < 4; ++m) _Pragma("unroll") for (int n = 0; n < 2; ++n) { \
        if constexpr (FP8) mfma_f8(acc[ai][bj][m][n], Bt##8[n], At##8[m]); \
        else { _Pragma("unroll") for (int k = 0; k < 2; ++k) acc[ai][bj][m][n] = __builtin_amdgcn_mfma_f32_16x16x32_bf16(Bt[n][k], At[m][k], acc[ai][bj][m][n], 0, 0, 0); } } \
        __builtin_amdgcn_s_setprio(0); } while (0)
#define PG_WAIT_V(n) asm volatile("s_waitcnt vmcnt(" #n ")" ::: "memory")
#define PG_WAIT_L(n) asm volatile("s_waitcnt lgkmcnt(" #n ")" ::: "memory")
#define PG_BAR __builtin_amdgcn_s_barrier()
#define PG_SCHED __builtin_amdgcn_sched_barrier(0)
    Unit cur, nxt, nn; int ui = 0;
    if (!S.next(0, cur)) return;
    bool has_next = S.next(1, nxt);
    f32x4 acc[2][2][4][2];
#pragma unroll
    for (int a = 0; a < 2; ++a)
#pragma unroll
        for (int b = 0; b < 2; ++b)
#pragma unroll
            for (int m = 0; m < 4; ++m)
#pragma unroll
                for (int n = 0; n < 2; ++n) acc[a][b][m][n] = (f32x4){0.f, 0.f, 0.f, 0.f};
    if constexpr (FP8) {
#pragma unroll
    for (int a = 0; a < 2; ++a)
#pragma unroll
        for (int b = 0; b < 2; ++b) asm volatile("" : "+v"(acc[a][b][0][0]), "+v"(acc[a][b][0][1]), "+v"(acc[a][b][1][0]), "+v"(acc[a][b][1][1]), "+v"(acc[a][b][2][0]), "+v"(acc[a][b][2][1]), "+v"(acc[a][b][3][0]), "+v"(acc[a][b][3][1]));
    }
    bf16x8 At[4][2], B0[2][2], B1[2][2]; i32x8 At8[4], B08[2], B18[2];
    const char* cA = cur.A; const char* cB = cur.B;
    if (GATHER) { PG_ROWS(cur, vAc);
        if (has_next && wid < 4) PG_GLDS4(nxt.rows + tid, ROWS_OFF + 1024 + wid * 256); }
    PG_STAGE_B(PG_SB(0, 0), cB); PG_STAGE_A(PG_SA(0, 0), cA, 0, false); PG_STAGE_B(PG_SB(0, 1), cB + hstep); PG_STAGE_A(PG_SA(0, 1), cA, 1, false);
    if (wr == 1) PG_BAR;
    PG_WAIT_V(4); PG_BAR;
    PG_STAGE_B(PG_SB(1, 0), cB + kstep); PG_STAGE_A(PG_SA(1, 0), cA + kstep, 0, false); PG_STAGE_B(PG_SB(1, 1), cB + hstep + kstep);
    PG_WAIT_V(6); PG_BAR;
    for (;;) {
        const bool has_nn = has_next ? S.next(ui + 2, nn) : false;
        const char* nA = has_next ? nxt.A : cA; const char* nB = has_next ? nxt.B : cB;
        if (GATHER) { if (has_nn && wid < 4) PG_GLDS4(nn.rows + tid, ROWS_OFF + (ui & 1) * 1024 + wid * 256);
            if (has_next) { const LAS int* rs = (const LAS int*)(lds + ROWS_OFF + ((ui + 1) & 1) * 1024);
#pragma unroll
            for (int h = 0; h < 2; ++h)
#pragma unroll
                for (int i = 0; i < 2; ++i) vAn[h][i] = (unsigned)(rs[h * HALF + RA[i]] * KB + CA[i] * 2); } else {
#pragma unroll
            for (int h = 0; h < 2; ++h)
#pragma unroll
                for (int i = 0; i < 2; ++i) vAn[h][i] = vAc[h][i]; } }
        if constexpr (Epi::PRE) E.pre(lds, cur, ui, tid, wid);
#pragma unroll 1
        for (int t = 0; t < nt; t += 2) {
            const bool last = (t == nt - 2);
            const char* a1 = cA + (size_t)(t + 1) * kstep;
            const char* a2 = last ? nA : cA + (size_t)(t + 2) * kstep; const char* b2 = last ? nB : cB + (size_t)(t + 2) * kstep;
            const char* a3 = a2 + kstep; const char* b3 = b2 + kstep;
            PG_LDB(B0, 0, 0); PG_SCHED; PG_LDA(At, 0, 0); PG_STAGE_A(PG_SA(1, 1), a1, 1, false);
            PG_WAIT_L(8); PG_BAR; PG_WAIT_L(0); PG_MMA(0, 0, At, B0); PG_BAR; PG_SCHED;
            PG_LDB(B1, 0, 1); PG_STAGE_B(PG_SB(0, 0), b2);
            PG_BAR; PG_WAIT_L(0); PG_MMA(0, 1, At, B1); PG_BAR;
            PG_LDA(At, 0, 1); PG_STAGE_A(PG_SA(0, 0), a2, 0, last);
            PG_BAR; PG_WAIT_L(0); PG_MMA(1, 0, At, B0); PG_BAR; PG_SCHED;
            PG_STAGE_B(PG_SB(0, 1), b2 + hstep);
            PG_WAIT_V(6); PG_BAR; PG_MMA(1, 1, At, B1); PG_BAR;
            PG_LDB(B0, 1, 0); PG_SCHED; PG_LDA(At, 1, 0); PG_STAGE_A(PG_SA(0, 1), a2, 1, last);
            PG_WAIT_L(8); PG_BAR; PG_WAIT_L(0); PG_MMA(0, 0, At, B0); PG_BAR; PG_SCHED;
            PG_LDB(B1, 1, 1); PG_STAGE_B(PG_SB(1, 0), b3);
            PG_BAR; PG_WAIT_L(0); PG_MMA(0, 1, At, B1); PG_BAR;
            PG_LDA(At, 1, 1); PG_STAGE_A(PG_SA(1, 0), a3, 0, last);
            PG_BAR; PG_WAIT_L(0); PG_MMA(1, 0, At, B0); PG_BAR; PG_SCHED;
            PG_STAGE_B(PG_SB(1, 1), b3 + hstep);
            PG_WAIT_V(6); PG_BAR; PG_MMA(1, 1, At, B1); PG_BAR;
        }
        if constexpr (FP8) asm volatile("s_nop 15\n\ts_nop 15" ::: "memory");
        if constexpr (Epi::PRE) E.run(acc, cur, wr, wc, fr, fq, lds, ui); else E(acc, cur, wr, wc, fr, fq);
        if (!has_next) break;
#pragma unroll
        for (int a = 0; a < 2; ++a)
#pragma unroll
            for (int b = 0; b < 2; ++b)
#pragma unroll
                for (int m = 0; m < 4; ++m)
#pragma unroll
                    for (int n = 0; n < 2; ++n) acc[a][b][m][n] = (f32x4){0.f, 0.f, 0.f, 0.f};
        if constexpr (FP8) {
#pragma unroll
        for (int a = 0; a < 2; ++a)
#pragma unroll
            for (int b = 0; b < 2; ++b) asm volatile("" : "+v"(acc[a][b][0][0]), "+v"(acc[a][b][0][1]), "+v"(acc[a][b][1][0]), "+v"(acc[a][b][1][1]), "+v"(acc[a][b][2][0]), "+v"(acc[a][b][2][1]), "+v"(acc[a][b][3][0]), "+v"(acc[a][b][3][1]));
        }
        cur = nxt; cA = nA; cB = nB; ++ui; nxt = nn; has_next = has_nn;
        if (GATHER) {
#pragma unroll
            for (int h = 0; h < 2; ++h)
#pragma unroll
                for (int i = 0; i < 2; ++i) vAc[h][i] = vAn[h][i]; }
    }
    PG_WAIT_V(0);
    if (wr == 0) PG_BAR;
    PG_BAR;
#undef PG_SA
#undef PG_SB
#undef PG_GLDS
#undef PG_GLDS4
#undef PG_STAGE_A
#undef PG_STAGE_B
#undef PG_ROWS
#undef PG_LD8
#undef PG_LDA
#undef PG_LDB
#undef PG_MMA
#undef PG_WAIT_V
#undef PG_WAIT_L
#undef PG_BAR
#undef PG_SCHED
}

struct DenseOrder {
    const char* A; const char* Bt; int KB, nM, nN, nwg, G, c; int own = 0;
    __device__ __forceinline__ bool next(int i, Unit& u) const {
        if (own) { if (i >= nN) return false; u.pm = c; u.pn = i; u.rows = nullptr; u.aux = 0; u.A = A + (size_t)u.pm * 256 * KB; u.B = Bt + (size_t)u.pn * 256 * KB; return true; }
        const long L = (long)i * G + c; if (L >= nwg) return false;
        const int wgid = xcd_remap((int)L, nwg);
        const int nig = 8 * nN, gid = wgid / nig, fm = gid * 8, gsz = (nM - fm) < 8 ? (nM - fm) : 8;
        u.pm = fm + ((wgid % nig) % gsz); u.pn = (wgid % nig) / gsz; u.rows = nullptr; u.aux = 0;
        u.A = A + (size_t)u.pm * 256 * KB; u.B = Bt + (size_t)u.pn * 256 * KB; return true;
    }
};

struct EpiP2 {
    static constexpr bool PERM = true, DBL = false, PRE = false;
    bf16 *PQK, *PV, *PO, *RAW, *PZ; float* GATES;
    __device__ __forceinline__ void operator()(const f32x4 (&acc)[2][2][4][2], const Unit& u, int wr, int wc, int fr, int fq) const {
        const int row0 = u.pm * BM + wr * 64 + fr, pn = u.pn;
        if (pn == 14) {
            if (wc == 0) {
#pragma unroll
                for (int ai = 0; ai < 2; ++ai)
#pragma unroll
                    for (int m = 0; m < 4; ++m) { float* g = GATES + (size_t)(row0 + ai * HALF + m * 16) * 32 + 8 * fq; *(f32x4*)g = acc[ai][0][m][0]; *(f32x4*)(g + 4) = acc[ai][0][m][1]; }
            }
            return;
        }
        bf16* base; int ldc = 512;
        if (pn < 2) base = PQK + pn * 256; else if (pn < 4) base = PV + (pn - 2) * 256; else if (pn < 6) base = PO + (pn - 4) * 256;
        else if (pn < 12) { base = RAW + (pn - 6) * 256; ldc = 1536; } else base = PZ + (pn - 12) * 256;
        const int col0 = wc * 32 + 8 * fq;
#pragma unroll
        for (int ai = 0; ai < 2; ++ai)
#pragma unroll
            for (int m = 0; m < 4; ++m) { bf16* rowp = base + (size_t)(row0 + ai * HALF + m * 16) * ldc + col0;
#pragma unroll
                for (int bj = 0; bj < 2; ++bj) { const f32x4 v0 = acc[ai][bj][m][0], v1 = acc[ai][bj][m][1];
                    u32x4 w; w.x = cvt_pk_bf16(v0[0], v0[1]); w.y = cvt_pk_bf16(v0[2], v0[3]); w.z = cvt_pk_bf16(v1[0], v1[1]); w.w = cvt_pk_bf16(v1[2], v1[3]);
                    *(u32x4*)(rowp + bj * HALF) = w; } }
    }
};
struct EpiBf16 {
    static constexpr bool PERM = true, DBL = false, PRE = false;
    bf16* O; int ldc;
    __device__ __forceinline__ void operator()(const f32x4 (&acc)[2][2][4][2], const Unit& u, int wr, int wc, int fr, int fq) const {
        const int row0 = u.pm * BM + wr * 64 + fr, col0 = u.pn * BM + wc * 32 + 8 * fq;
#pragma unroll
        for (int ai = 0; ai < 2; ++ai)
#pragma unroll
            for (int m = 0; m < 4; ++m) { bf16* rowp = O + (size_t)(row0 + ai * HALF + m * 16) * ldc + col0;
#pragma unroll
                for (int bj = 0; bj < 2; ++bj) { const f32x4 v0 = acc[ai][bj][m][0], v1 = acc[ai][bj][m][1];
                    u32x4 w; w.x = cvt_pk_bf16(v0[0], v0[1]); w.y = cvt_pk_bf16(v0[2], v0[3]); w.z = cvt_pk_bf16(v1[0], v1[1]); w.w = cvt_pk_bf16(v1[2], v1[3]);
                    *(u32x4*)(rowp + bj * HALF) = w; } }
    }
};
struct EpiGU {
    static constexpr bool PERM = true, DBL = false, PRE = false;
    bf16* O;
    __device__ __forceinline__ void operator()(const f32x4 (&acc)[2][2][4][2], const Unit& u, int wr, int wc, int fr, int fq) const {
        const int row0 = u.pm * BM + wr * 64 + fr, col0 = u.pn * HALF + wc * 32 + 8 * fq;
#pragma unroll
        for (int ai = 0; ai < 2; ++ai)
#pragma unroll
            for (int m = 0; m < 4; ++m) { float h[8];
#pragma unroll
                for (int n = 0; n < 2; ++n)
#pragma unroll
                    for (int j = 0; j < 4; ++j) { const float g = acc[ai][0][m][n][j], up = acc[ai][1][m][n][j]; h[n * 4 + j] = g * __builtin_amdgcn_rcpf(1.0f + __expf(-g)) * up; }
                u32x4 w; w.x = cvt_pk_bf16(h[0], h[1]); w.y = cvt_pk_bf16(h[2], h[3]); w.z = cvt_pk_bf16(h[4], h[5]); w.w = cvt_pk_bf16(h[6], h[7]);
                *(u32x4*)(O + (size_t)(row0 + ai * HALF + m * 16) * 256 + col0) = w; }
    }
};
struct EpiGU8 {
    static constexpr bool PERM = true, DBL = false, PRE = false;
    unsigned char* O;
    __device__ __forceinline__ void operator()(const f32x4 (&acc)[2][2][4][2], const Unit& u, int wr, int wc, int fr, int fq) const {
        const int row0 = u.pm * BM + wr * 64 + fr, col0 = u.pn * HALF + wc * 32 + 8 * fq;
#pragma unroll
        for (int ai = 0; ai < 2; ++ai)
#pragma unroll
            for (int m = 0; m < 4; ++m) { float h[8];
#pragma unroll
                for (int n = 0; n < 2; ++n)
#pragma unroll
                    for (int j = 0; j < 4; ++j) { const float g = acc[ai][0][m][n][j] * (1.f / 64.f), up = acc[ai][1][m][n][j] * (8.f / 64.f);
                        h[n * 4 + j] = fminf(fmaxf(g * __builtin_amdgcn_rcpf(1.0f + __expf(-g)) * up, -448.f), 448.f); }
                int lo = 0, hi = 0;
                lo = __builtin_amdgcn_cvt_pk_fp8_f32(h[0], h[1], lo, false); lo = __builtin_amdgcn_cvt_pk_fp8_f32(h[2], h[3], lo, true);
                hi = __builtin_amdgcn_cvt_pk_fp8_f32(h[4], h[5], hi, false); hi = __builtin_amdgcn_cvt_pk_fp8_f32(h[6], h[7], hi, true);
                typedef unsigned u32x2 __attribute__((ext_vector_type(2))); u32x2 o; o.x = (unsigned)lo; o.y = (unsigned)hi;
                *(u32x2*)(O + (size_t)(row0 + ai * HALF + m * 16) * 256 + col0) = o; }
    }
};
struct EpiF32 {
    static constexpr bool PERM = false, DBL = false, PRE = false;
    float* C0; float* C1; int ldc;
    __device__ __forceinline__ void operator()(const f32x4 (&acc)[2][2][4][2], const Unit& u, int wr, int wc, int fr, int fq) const {
        float* C = u.pn ? C1 : C0;
        const int row0 = u.pm * BM + wr * 64 + fr, col0 = wc * 32 + 4 * fq;
#pragma unroll
        for (int ai = 0; ai < 2; ++ai)
#pragma unroll
            for (int m = 0; m < 4; ++m) { float* rowp = C + (size_t)(row0 + ai * HALF + m * 16) * ldc + col0;
#pragma unroll
                for (int bj = 0; bj < 2; ++bj)
#pragma unroll
                    for (int n = 0; n < 2; ++n) *(f32x4*)(rowp + bj * HALF + n * 16) = acc[ai][bj][m][n]; }
    }
};
template <bool SHARED, bool NOST = false> struct EpiContrib {
    static constexpr bool PERM = true, DBL = true, PRE = !SHARED;
    unsigned char* C; const int* LDST; const float* LW;
    __device__ __forceinline__ void pre(LAS unsigned char* lds, const Unit& u, int ui, int tid, int wid) const {
        const int p = u.pm * BM + (tid & 255);
        const void* g = wid < 4 ? (const void*)(LDST + p) : (const void*)(LW + p);
        __builtin_amdgcn_global_load_lds((const unsigned*)g, (LAS unsigned*)(lds + DW_OFF + (ui & 1) * 2048 + wid * 256), 4, 0, 0);
    }
    __device__ __forceinline__ void operator()(const f32x4 (&acc)[2][2][4][2], const Unit& u, int wr, int wc, int fr, int fq) const { run(acc, u, wr, wc, fr, fq, nullptr, 0); }
    __device__ __forceinline__ void run(const f32x4 (&acc)[2][2][4][2], const Unit& u, int wr, int wc, int fr, int fq, LAS unsigned char* lds, int ui) const {
        const int row0 = u.pm * BM + wr * 64 + fr, col0 = u.pn * BM + wc * 32 + 8 * fq;
        int dstv[8]; float wv[8];
        const LAS int* sd = (const LAS int*)(lds + DW_OFF + (ui & 1) * 2048); const LAS float* sw = (const LAS float*)(sd + 256);
#pragma unroll
        for (int i = 0; i < 8; ++i) { const int p = row0 + (i >> 2) * HALF + (i & 3) * 16, pl = wr * 64 + fr + (i >> 2) * HALF + (i & 3) * 16;
            if constexpr (SHARED) { dstv[i] = p * 9 + 8; wv[i] = 16.f / 256.f; } else { dstv[i] = sd[pl]; wv[i] = sw[pl] * (16.f / 256.f); } }
#pragma unroll
        for (int ai = 0; ai < 2; ++ai)
#pragma unroll
            for (int m = 0; m < 4; ++m) { const int dst = dstv[ai * 4 + m]; const float w = wv[ai * 4 + m];
                if (dst >= 0) { unsigned char* rowp = C + (size_t)dst * 1024 + col0;
#pragma unroll
                    for (int bj = 0; bj < 2; ++bj) { f32x4 v0 = acc[ai][bj][m][0] * w, v1 = acc[ai][bj][m][1] * w;
#pragma unroll
                        for (int j = 0; j < 4; ++j) { v0[j] = fminf(fmaxf(v0[j], -448.f), 448.f); v1[j] = fminf(fmaxf(v1[j], -448.f), 448.f); }
                        int lo = 0, hi = 0;
                        lo = __builtin_amdgcn_cvt_pk_fp8_f32(v0[0], v0[1], lo, false); lo = __builtin_amdgcn_cvt_pk_fp8_f32(v0[2], v0[3], lo, true);
                        hi = __builtin_amdgcn_cvt_pk_fp8_f32(v1[0], v1[1], hi, false); hi = __builtin_amdgcn_cvt_pk_fp8_f32(v1[2], v1[3], hi, true);
                        typedef unsigned u32x2 __attribute__((ext_vector_type(2))); u32x2 o; o.x = (unsigned)lo; o.y = (unsigned)hi;
                        if constexpr (NOST) asm volatile("" :: "v"(o), "v"(rowp)); else *(u32x2*)(rowp + bj * HALF) = o; } } }
    }
};

struct RoutedGuOrder {
    const char* HFFN; const char* WguT; const int* LTOK; const LAS int* TE; int KB, ntot, G, c;
    __device__ __forceinline__ bool next(int i, Unit& u) const {
        const long L = (long)i * G + c; if (L >= ntot) return false;
        const int nat = xcd_remap((int)L, ntot), r = nat >> 1, pn = nat & 1, e = TE[r];
        u.pm = r; u.pn = pn; u.aux = e; u.rows = LTOK + (size_t)r * 256; u.A = HFFN; u.B = WguT + ((size_t)e * 512 + pn * 256) * KB; return true;
    }
};
struct RoutedDownOrder {
    const char* HB; const char* WdT; const LAS int* TE; int KB, r0, ntot, G, c;
    __device__ __forceinline__ bool next(int i, Unit& u) const {
        const long L = (long)i * G + c; if (L >= ntot) return false;
        const int nat = xcd_remap((int)L, ntot), r = r0 + (nat >> 2), pn = nat & 3, e = TE[r];
        u.pm = r; u.pn = pn; u.aux = e; u.rows = nullptr; u.A = HB + (size_t)r * 256 * KB; u.B = WdT + ((size_t)e * 1024 + pn * 256) * KB; return true;
    }
};
}

template <bool LO = false, class RM>
__device__ __forceinline__ void transpose_item(const float* W, int K, int N, bf16* WT, LAS float* scr, int item, int lane, const RM& rm) {
    const int nblk = N / 32, kb = item / nblk, nb = item % nblk, k0 = 64 * kb, n0 = 32 * nb;
#pragma unroll 8
    for (int i = 0; i < 32; ++i) { const int kk = 2 * i + (lane >> 5); float wv = W[(size_t)(k0 + kk) * N + n0 + (lane & 31)]; if (LO) wv -= bf2f(f2bf(wv)); scr[kk * 33 + (lane & 31)] = wv; }
    asm volatile("s_waitcnt lgkmcnt(0)" ::: "memory");
    const int c = lane & 7;
#pragma unroll
    for (int j = 0; j < 4; ++j) { const int n = (lane >> 3) + 8 * j; const LAS float* s = scr + (8 * c) * 33 + n; int row; float sc; rm(n0 + n, row, sc);
        uint4 o; o.x = (unsigned)f2bf(s[0 * 33] * sc) | ((unsigned)f2bf(s[1 * 33] * sc) << 16); o.y = (unsigned)f2bf(s[2 * 33] * sc) | ((unsigned)f2bf(s[3 * 33] * sc) << 16);
        o.z = (unsigned)f2bf(s[4 * 33] * sc) | ((unsigned)f2bf(s[5 * 33] * sc) << 16); o.w = (unsigned)f2bf(s[6 * 33] * sc) | ((unsigned)f2bf(s[7 * 33] * sc) << 16);
        *(uint4*)(WT + (size_t)row * K + k0 + 8 * c) = o; }
    asm volatile("s_waitcnt lgkmcnt(0)" ::: "memory");
}

template <class RM>
__device__ __forceinline__ void transpose_item_f8(const float* W, int K, int N, unsigned char* WT, LAS float* scr, int item, int lane, const RM& rm) {
    const int nblk = N / 32, kb = item / nblk, nb = item % nblk, k0 = 64 * kb, n0 = 32 * nb;
#pragma unroll 8
    for (int i = 0; i < 32; ++i) { const int kk = 2 * i + (lane >> 5); scr[kk * 33 + (lane & 31)] = W[(size_t)(k0 + kk) * N + n0 + (lane & 31)]; }
    asm volatile("s_waitcnt lgkmcnt(0)" ::: "memory");
    const int c = lane & 7;
#pragma unroll
    for (int j = 0; j < 4; ++j) { const int n = (lane >> 3) + 8 * j; const LAS float* s = scr + (8 * c) * 33 + n; int row; float sc; rm(n0 + n, row, sc);
        int lo = 0, hi = 0;
        lo = __builtin_amdgcn_cvt_pk_fp8_f32(s[0 * 33] * sc, s[1 * 33] * sc, lo, false); lo = __builtin_amdgcn_cvt_pk_fp8_f32(s[2 * 33] * sc, s[3 * 33] * sc, lo, true);
        hi = __builtin_amdgcn_cvt_pk_fp8_f32(s[4 * 33] * sc, s[5 * 33] * sc, hi, false); hi = __builtin_amdgcn_cvt_pk_fp8_f32(s[6 * 33] * sc, s[7 * 33] * sc, hi, true);
        typedef unsigned u32x2 __attribute__((ext_vector_type(2))); u32x2 o; o.x = (unsigned)lo; o.y = (unsigned)hi;
        *(u32x2*)(WT + (size_t)row * K + k0 + 8 * c) = o; }
    asm volatile("s_waitcnt lgkmcnt(0)" ::: "memory");
}

typedef float cf32x4 __attribute__((ext_vector_type(4)));
typedef unsigned cu32x4 __attribute__((ext_vector_type(4)));
template <class RM>
__device__ __forceinline__ void conv_tile_f8(const float* W, int K, int N, unsigned char* WT, LAS float* scr, int k0, int n0, int lane, const RM& rm) {
    cf32x4 v[16];
    const float* src = W + (size_t)(k0 + (lane >> 3)) * N + n0 + (lane & 7) * 4;
#pragma unroll
    for (int i = 0; i < 16; ++i) v[i] = *(const cf32x4*)(src + (size_t)(8 * i) * N);
#pragma unroll
    for (int i = 0; i < 16; ++i) { LAS float* d = scr + (8 * i + (lane >> 3)) * 33 + (lane & 7) * 4; d[0] = v[i][0]; d[1] = v[i][1]; d[2] = v[i][2]; d[3] = v[i][3]; }
    asm volatile("s_waitcnt lgkmcnt(0)" ::: "memory");
    const int kc = lane & 7;
#pragma unroll
    for (int j = 0; j < 4; ++j) { const int n = (lane >> 3) + 8 * j; int row; float sc; rm(n0 + n, row, sc);
        const LAS float* s = scr + (16 * kc) * 33 + n; cu32x4 o;
#pragma unroll
        for (int q = 0; q < 4; ++q) { int p = 0; p = __builtin_amdgcn_cvt_pk_fp8_f32(s[(4 * q) * 33] * sc, s[(4 * q + 1) * 33] * sc, p, false); p = __builtin_amdgcn_cvt_pk_fp8_f32(s[(4 * q + 2) * 33] * sc, s[(4 * q + 3) * 33] * sc, p, true); o[q] = (unsigned)p; }
        *(cu32x4*)(WT + (size_t)row * K + k0 + 16 * kc) = o; }
    asm volatile("s_waitcnt lgkmcnt(0)" ::: "memory");
}
__device__ __forceinline__ void conv_chunk(const float* wg, const float* wu, const float* wd, unsigned char* WGU8, unsigned char* WD8, LAS float* scr, int q, int c, int lane) {
    if (q == 0 && c < 4096) { const int e = c >> 4, r = c & 15, kb = r >> 3, nb4 = r & 7;
#pragma unroll 1
        for (int s = 0; s < 4; ++s) conv_tile_f8(wd + (size_t)e * DE * D, DE, D, WD8 + (size_t)e * D * DE, scr, 128 * kb, 32 * (4 * nb4 + s), lane, [](int n, int& row, float& sc) { sc = 32.f; row = n; });
    } else { const int cc = q == 0 ? c - 4096 : c, e = (q == 0 ? 0 : 128) + (cc >> 5), r = cc & 31, mat = r >> 4, kb = (r & 15) >> 1, nb4 = r & 1;
        const float* W = (mat ? wu : wg) + (size_t)e * D * DE;
#pragma unroll 1
        for (int s = 0; s < 4; ++s) conv_tile_f8(W, D, DE, WGU8 + (size_t)e * 512 * D, scr, 128 * kb, 32 * (4 * nb4 + s), lane, [mat](int n, int& row, float& sc) { sc = 64.f; row = 256 * (n >> 7) + 128 * mat + (n & 127); });
    }
}

typedef short bf16x8 __attribute__((ext_vector_type(8)));
typedef unsigned u4v __attribute__((ext_vector_type(4)));
typedef unsigned u2v __attribute__((ext_vector_type(2)));
__device__ __forceinline__ u4v mk4(unsigned a, unsigned b, unsigned c, unsigned d) { u4v r; r.x = a; r.y = b; r.z = c; r.w = d; return r; }
__device__ __forceinline__ u2v mk2(unsigned a, unsigned b) { u2v r; r.x = a; r.y = b; return r; }
#define MFMA16(a, b, c) __builtin_amdgcn_mfma_f32_16x16x32_bf16(a, b, c, 0, 0, 0)
__device__ __forceinline__ bf16x8 ldfrag(const LAS bf16* base, int pitch, int r0, int k0, int lane) { return *(const LAS bf16x8*)(base + (r0 + (lane & 15)) * pitch + k0 + 8 * (lane >> 4)); }
__device__ __forceinline__ void lds8(const LAS float* p, float (&f)[8]) { const f32x4 a = *(const LAS f32x4*)p, b = *(const LAS f32x4*)(p + 4); f[0] = a[0]; f[1] = a[1]; f[2] = a[2]; f[3] = a[3]; f[4] = b[0]; f[5] = b[1]; f[6] = b[2]; f[7] = b[3]; }
__device__ __forceinline__ unsigned pk2(float lo, float hi) { return (unsigned)f2bf(lo) | ((unsigned)f2bf(hi) << 16); }
__device__ __forceinline__ void unpack8(const u4v& u, float (&f)[8]) {
    f[0] = bf2f((bf16)(u.x & 0xffffu)); f[1] = bf2f((bf16)(u.x >> 16)); f[2] = bf2f((bf16)(u.y & 0xffffu)); f[3] = bf2f((bf16)(u.y >> 16));
    f[4] = bf2f((bf16)(u.z & 0xffffu)); f[5] = bf2f((bf16)(u.z >> 16)); f[6] = bf2f((bf16)(u.w & 0xffffu)); f[7] = bf2f((bf16)(u.w >> 16)); }
__device__ __forceinline__ u4v pack8(const float (&f)[8]) { return mk4(pk2(f[0], f[1]), pk2(f[2], f[3]), pk2(f[4], f[5]), pk2(f[6], f[7])); }
constexpr int NCH = 132;
constexpr int MSCN = 336, GSCN = 272;
struct ScanBufs {
    const bf16 *PQK, *PV, *RAW; const float* GATES;
    bf16 *MQ, *MKT, *MQK, *MVT; float* MSC;
    bf16 *GQ, *GKT, *GVT, *GQK, *GT; float* GSC;
    bf16 *HML, *OGD;
    const float *ib, *fb, *cw, *alog, *dtb;
};
__device__ __forceinline__ int chunk_row(int b, int c, int t, bool gdn) {
    if (c < 4) return T + b * CTXL + 64 * c + t;
    const int cl = c - 4;
    return gdn ? b * SEQ + ((cl & 1) * 64 + t) * GW_ + (cl >> 1) : b * SEQ + 64 * cl + t;
}

#define LDS_BARRIER() do { asm volatile("s_waitcnt lgkmcnt(0)" ::: "memory"); __builtin_amdgcn_s_barrier(); asm volatile("" ::: "memory"); } while (0)
struct PrepMRegs { u4v q, k, v[2]; float fp, ip; };
__device__ __forceinline__ void prep_mlstm_load(const ScanBufs& sb, PrepMRegs& R, int b, int h, int c) {
    const int tid = opaque((int)threadIdx.x), lane = tid & 63, wave = __builtin_amdgcn_readfirstlane(tid >> 6);
    const int row0 = chunk_row(b, c, 0, false); const int t = tid >> 3, p = tid & 7;
    R.q = *(const u4v*)(sb.PQK + (size_t)(row0 + t) * 512 + h * 64 + p * 8); R.k = *(const u4v*)(sb.PQK + (size_t)(row0 + t) * 512 + 256 + h * 64 + p * 8);
#pragma unroll
    for (int i = 0; i < 2; ++i) { const int idx = tid + i * NTHR, tv = idx >> 4, pv = idx & 15; R.v[i] = *(const u4v*)(sb.PV + (size_t)(row0 + tv) * 512 + h * 128 + pv * 8); }
    R.fp = 0.f; R.ip = 0.f;
    if (wave == 0 || wave == 4) { const int dir = wave >> 2, tt = dir ? 63 - lane : lane;
        R.fp = sb.GATES[(size_t)(row0 + tt) * 32 + dir * 8 + 4 + h]; R.ip = sb.GATES[(size_t)(row0 + tt) * 32 + dir * 8 + h]; }
}
template <class NextLoad>
__device__ __forceinline__ void prep_mlstm_item(const ScanBufs& sb, LAS unsigned char* lds, int b, int h, int c, PrepMRegs& R, const NextLoad& next_load) {
    const int tid = opaque((int)threadIdx.x), lane = tid & 63, wave = __builtin_amdgcn_readfirstlane(tid >> 6);
    LAS bf16* Qs = (LAS bf16*)lds; LAS bf16* Ks = Qs + 64 * 72; LAS bf16* Vs = Ks + 64 * 72;
    LAS float* QKf = (LAS float*)(Vs + 64 * 136); LAS float* SC = QKf + 64 * 65;
    const int item = (b * 4 + h) * NCH + c;
    const int row0 = chunk_row(b, c, 0, false);
    const float gfp = R.fp, gip = R.ip;
    { const int t = tid >> 3, p = tid & 7;
      const u4v qv = R.q, kv = R.k;
      *(LAS u4v*)(Qs + t * 72 + p * 8) = qv; *(LAS u4v*)(Ks + t * 72 + p * 8) = kv;
      *(u4v*)(sb.MQ + (size_t)item * 4096 + t * 64 + p * 8) = qv;
#pragma unroll
      for (int i = 0; i < 2; ++i) { const int idx = tid + i * NTHR, tv = idx >> 4, pv = idx & 15;
          *(LAS u4v*)(Vs + tv * 136 + pv * 8) = R.v[i]; } }
    next_load();
    LDS_BARRIER();
    { const int d = tid >> 3, t0 = (tid & 7) * 8; float f[8];
#pragma unroll
      for (int e = 0; e < 8; ++e) f[e] = bf2f(Ks[(t0 + e) * 72 + d]);
      *(u4v*)(sb.MKT + (size_t)item * 4096 + d * 64 + t0) = pack8(f);
#pragma unroll
      for (int i = 0; i < 2; ++i) { const int idx = tid + i * NTHR, dv = idx >> 3, tv0 = (idx & 7) * 8;
#pragma unroll
          for (int e = 0; e < 8; ++e) f[e] = bf2f(Vs[(tv0 + e) * 136 + dv]);
          *(u4v*)(sb.MVT + (size_t)item * 8192 + dv * 64 + tv0) = pack8(f); } }
    { const int rt = wave >> 1;
#pragma unroll
      for (int cc = 0; cc < 2; ++cc) { const int ct = 2 * (wave & 1) + cc; f32x4 acc = {0.f, 0.f, 0.f, 0.f};
#pragma unroll
          for (int ks = 0; ks < 2; ++ks) acc = MFMA16(ldfrag(Qs, 72, 16 * rt, 32 * ks, lane), ldfrag(Ks, 72, 16 * ct, 32 * ks, lane), acc);
#pragma unroll
          for (int j = 0; j < 4; ++j) QKf[(16 * rt + 4 * (lane >> 4) + j) * 65 + 16 * ct + (lane & 15)] = acc[j]; } }
    if (wave == 0 || wave == 4) {
        const int dir = wave >> 2, t = dir ? 63 - lane : lane;
        const LAS float* BT = (const LAS float*)(lds + 163840 - 512);
        const float fp = gfp + BT[8 + dir * 4 + h], ip = gip + BT[dir * 4 + h];
        float a = fp > 0.f ? -log1pf(__expf(-fp)) : fp - log1pf(__expf(fp));
#pragma unroll
        for (int o = 1; o < 64; o <<= 1) { const float v = __shfl_up(a, o); if (lane >= o) a += v; }
        const float bend = __shfl(a, 63), wsv = __expf(bend - a + ip);
        SC[(dir * 3 + 0) * 64 + t] = a; SC[(dir * 3 + 1) * 64 + t] = ip; SC[(dir * 3 + 2) * 64 + t] = wsv;
        float* ms = sb.MSC + ((size_t)((b * 4 + h) * 2 + dir) * NCH + c) * MSCN;
        ms[t] = a; ms[64 + t] = ip; ms[128 + t] = wsv; if (lane == 0) ms[320] = __expf(bend);
    }
    LDS_BARRIER();
    { const int t = tid >> 3, s0 = (tid & 7) * 8; float f[8];
#pragma unroll
      for (int e = 0; e < 8; ++e) f[e] = QKf[t * 65 + s0 + e];
      *(u4v*)(sb.MQK + (size_t)item * 4096 + t * 64 + s0) = pack8(f); }
    { const int dir = tid >> 8, u = tid & 255, r = u >> 2, part = u & 3;
      const LAS float* bb = SC + (dir * 3) * 64; const LAS float* ipp = bb + 64; const LAS float* wss = bb + 128;
      float den = 0.f, ksum = 0.f; const float bt = bb[r];
#pragma unroll
      for (int e = 0; e < 16; ++e) { const int s = part * 16 + e; const bool le = dir ? (s >= r) : (s <= r);
          den += le ? QKf[r * 65 + s] * __expf(bt - bb[s] + ipp[s]) : 0.f; ksum += bf2f(Ks[s * 72 + r]) * wss[s]; }
      den += dpp_f<0xB1>(den); den += dpp_f<0x4E>(den); ksum += dpp_f<0xB1>(ksum); ksum += dpp_f<0x4E>(ksum);
      if (part == 0) { float* ms = sb.MSC + ((size_t)((b * 4 + h) * 2 + dir) * NCH + c) * MSCN; ms[192 + r] = den; ms[256 + r] = ksum; } }
    LDS_BARRIER();
}

struct PrepGRegs { u4v raw[7]; f32x4 cw; float ga, gb; };
__device__ __forceinline__ void prep_gdn_load(const ScanBufs& sb, PrepGRegs& R, int b, int h, int c) {
    const int tid = opaque((int)threadIdx.x), lane = tid & 63, wave = __builtin_amdgcn_readfirstlane(tid >> 6);
#pragma unroll
    for (int i = 0; i < 7; ++i) { const int idx = tid + i * NTHR; R.raw[i] = (u4v){0u, 0u, 0u, 0u};
        if (idx < 68 * 48) { const int rr = idx / 48, pc = idx % 48, sl = pc >> 4, off = (pc & 15) * 8; int row = -1;
            if (c < 4) { const int pos = 64 * c + rr - 2; if (pos >= 0 && pos < CTXL) row = T + b * CTXL + pos; }
            else { const int j = 64 * (c - 4) + rr - 2; if (j >= 0 && j < SEQ) row = b * SEQ + (j % ROWS) * GW_ + j / ROWS; }
            if (row >= 0) R.raw[i] = *(const u4v*)(sb.RAW + (size_t)row * 1536 + sl * 512 + h * 128 + off); } }
    R.cw = (f32x4){0.f, 0.f, 0.f, 0.f};
    if (tid < 480) { const int idx = tid * 4, w = idx / 384, ch = idx % 384; R.cw = *(const f32x4*)(sb.cw + w * 1536 + (ch >> 7) * 512 + h * 128 + (ch & 127)); }
    R.ga = 0.f; R.gb = 0.f;
    if (wave == 0 || wave == 4) { const int dir = wave >> 2, t = dir ? 63 - lane : lane; const int row = chunk_row(b, c, t, true);
        R.ga = sb.GATES[(size_t)row * 32 + 16 + dir * 8 + h]; R.gb = sb.GATES[(size_t)row * 32 + 16 + dir * 8 + 4 + h]; }
}
template <class NextLoad>
__device__ __forceinline__ void prep_gdn_item(const ScanBufs& sb, LAS unsigned char* lds, int b, int h, int c, PrepGRegs& R, const NextLoad& next_load) {
    const int tid = opaque((int)threadIdx.x), lane = tid & 63, wave = __builtin_amdgcn_readfirstlane(tid >> 6);
    LAS bf16* Raw = (LAS bf16*)lds;
    LAS bf16* Qs = (LAS bf16*)(lds + 53312); LAS bf16* Ks = Qs + 64 * 136; LAS bf16* Vs = Ks + 64 * 136;
    LAS float* KKf = (LAS float*)(lds + 105536); LAS float* QKf = KKf + 64 * 65;
    LAS float* CW = (LAS float*)(lds + 138816);
    LAS float* SCg = (LAS float*)(lds + 146496);
    LAS float* Lm = (LAS float*)lds;
    LAS bf16* Tout = (LAS bf16*)(lds + 32768);
    const int item = (b * 4 + h) * NCH + c;
    const float gga = R.ga, ggb = R.gb;
    const int tq = opaque(tid);
#pragma unroll
    for (int i = 0; i < 7; ++i) { const int idx = tq + i * NTHR;
        if (idx < 68 * 48) { const int rr = idx / 48, pc = idx % 48, sl = pc >> 4, off = (pc & 15) * 8; *(LAS u4v*)(Raw + rr * 392 + sl * 128 + off) = R.raw[i]; } }
    if (tq < 480) *(LAS f32x4*)(CW + tq * 4) = R.cw;
    next_load();
    LDS_BARRIER();
    for (int _d = 0; _d < (SCAN_DBL == 21 ? 2 : 1); ++_d) { const int t = tid >> 3, p = tid & 7;
#pragma unroll
      for (int sl = 0; sl < 3; ++sl) {
          float v[16]; float ss = 0.f;
#pragma unroll
          for (int e = 0; e < 16; ++e) v[e] = 0.f;
#pragma unroll
          for (int w = 0; w < 5; ++w) { const int ch0 = sl * 128 + 16 * p;
              const u4v r0 = *(const LAS u4v*)(Raw + (t + w) * 392 + ch0), r1 = *(const LAS u4v*)(Raw + (t + w) * 392 + ch0 + 8);
              float f0[8], f1[8]; unpack8(r0, f0); unpack8(r1, f1);
#pragma unroll
              for (int q4 = 0; q4 < 4; ++q4) { const f32x4 cwv = *(const LAS f32x4*)(CW + w * 384 + ch0 + q4 * 4);
#pragma unroll
                  for (int e = 0; e < 4; ++e) v[q4 * 4 + e] += (q4 < 2 ? f0[q4 * 4 + e] : f1[(q4 - 2) * 4 + e]) * cwv[e]; } }
#pragma unroll
          for (int e = 0; e < 16; ++e) { const float a = siluf_(v[e]); v[e] = a; ss += a * a; }
          if (sl < 2) { ss += dpp_f<0xB1>(ss); ss += dpp_f<0x4E>(ss); ss += dpp_f<0x141>(ss); const float r = rsqrtf(ss + EPS);
#pragma unroll
              for (int e = 0; e < 16; ++e) v[e] *= r; }
          LAS bf16* dst = (sl == 0 ? Qs : sl == 1 ? Ks : Vs) + t * 136 + 16 * p;
          *(LAS u4v*)dst = mk4(pk2(v[0], v[1]), pk2(v[2], v[3]), pk2(v[4], v[5]), pk2(v[6], v[7]));
          *(LAS u4v*)(dst + 8) = mk4(pk2(v[8], v[9]), pk2(v[10], v[11]), pk2(v[12], v[13]), pk2(v[14], v[15]));
      } }
    LDS_BARRIER();
    for (int _d = 0; _d < (SCAN_DBL == 22 ? 2 : 1); ++_d)
#pragma unroll
    for (int i = 0; i < 2; ++i) { const int idx = tid + i * NTHR;
        { const int t = idx >> 4, off = (idx & 15) * 8; *(u4v*)(sb.GQ + (size_t)item * 8192 + t * 128 + off) = *(const LAS u4v*)(Qs + t * 136 + off); }
        { const int dk = idx >> 3, t0 = (idx & 7) * 8; float f[8], g[8];
#pragma unroll
          for (int e = 0; e < 8; ++e) { f[e] = bf2f(Ks[(t0 + e) * 136 + dk]); g[e] = bf2f(Vs[(t0 + e) * 136 + dk]); }
          *(u4v*)(sb.GKT + (size_t)item * 8192 + dk * 64 + t0) = pack8(f); *(u4v*)(sb.GVT + (size_t)item * 8192 + dk * 64 + t0) = pack8(g); } }
    { const int rt = wave & 3; const LAS bf16* Am = wave < 4 ? Ks : Qs; LAS float* Out = wave < 4 ? KKf : QKf;
#pragma unroll
      for (int ct = 0; ct < 4; ++ct) { f32x4 acc = {0.f, 0.f, 0.f, 0.f};
#pragma unroll
          for (int ks = 0; ks < 4; ++ks) acc = MFMA16(ldfrag(Am, 136, 16 * rt, 32 * ks, lane), ldfrag(Ks, 136, 16 * ct, 32 * ks, lane), acc);
#pragma unroll
          for (int j = 0; j < 4; ++j) Out[(16 * rt + 4 * (lane >> 4) + j) * 65 + 16 * ct + (lane & 15)] = acc[j]; } }
    if (wave == 0 || wave == 4) {
        const int dir = wave >> 2, t = dir ? 63 - lane : lane; const int row = chunk_row(b, c, t, true);
        const float ga = gga, gb = ggb; (void)row;
        const LAS float* BT = (const LAS float*)(lds + 163840 - 512);
        float g = -__expf(BT[16 + dir * 4 + h]) * softplusf_(ga + BT[24 + dir * 4 + h]); const float beta = sigmoidf_(gb);
#pragma unroll
        for (int o = 1; o < 64; o <<= 1) { const float v = __shfl_up(g, o); if (lane >= o) g += v; }
        const float gend = __shfl(g, 63);
        SCg[(dir * 2) * 64 + t] = g; SCg[(dir * 2 + 1) * 64 + t] = beta;
        float* gs = sb.GSC + ((size_t)((b * 4 + h) * 2 + dir) * NCH + c) * GSCN;
        gs[t] = g; gs[64 + t] = beta * __expf(g); gs[128 + t] = beta; gs[192 + t] = __expf(gend - g); if (lane == 0) gs[256] = __expf(gend);
    }
    LDS_BARRIER();
    { const int t = tid >> 3, s0 = (tid & 7) * 8; float f[8];
#pragma unroll
      for (int e = 0; e < 8; ++e) f[e] = QKf[t * 65 + s0 + e];
      *(u4v*)(sb.GQK + (size_t)item * 4096 + t * 64 + s0) = pack8(f); }
    for (int idx = tid; idx < 2 * 4096; idx += NTHR) {
        const int dir = idx >> 12, p = (idx >> 6) & 63, q = idx & 63, tp = dir ? 63 - p : p, tq = dir ? 63 - q : q;
        const LAS float* Gd = SCg + (dir * 2) * 64;
        Lm[dir * 4096 + p * 64 + (q & 3) * 16 + (q >> 2)] = q < p ? Gd[64 + tp] * KKf[tp * 65 + tq] * __expf(Gd[tp] - Gd[tq]) : 0.f;
    }
    LDS_BARRIER();
    {
        const int dir = wave >> 2, col = (wave & 3) * 16 + (lane >> 2), pp = lane & 3;
        const LAS float* Ld = Lm + dir * 4096 + pp * 16;
        float Tq[16];
#pragma unroll
        for (int m = 0; m < 16; ++m) Tq[m] = 0.f;
        int lc = col; asm volatile("" : "+v"(lc));
#pragma unroll
        for (int i = 0; i < 64; ++i) {
            float s4[4] = {0.f, 0.f, 0.f, 0.f};
#pragma unroll
            for (int m4 = 0; m4 < (i + 15) / 16; ++m4) { const f32x4 l = *(const LAS f32x4*)(Ld + i * 64 + m4 * 4);
#pragma unroll
                for (int e = 0; e < 4; ++e) if (4 * (4 * m4 + e) < i) s4[e] += l[e] * Tq[4 * m4 + e]; }
            float s = (s4[0] + s4[1]) + (s4[2] + s4[3]);
            s += dpp_f<0xB1>(s); s += dpp_f<0x4E>(s);
            const float tv = ((lc == i) ? 1.f : 0.f) - s;
            if (pp == (i & 3)) Tq[i >> 2] = tv;
        }
        const int scol = dir ? 63 - col : col;
#pragma unroll
        for (int m = 0; m < 16; ++m) { const int i = 4 * m + pp; Tout[dir * 64 * 72 + (dir ? 63 - i : i) * 72 + scol] = f2bf(Tq[m]); }
    }
    LDS_BARRIER();
#pragma unroll
    for (int i = 0; i < 2; ++i) { const int idx = tid + i * NTHR, dir = idx >> 9, t = (idx >> 3) & 63, s0 = (idx & 7) * 8;
        *(u4v*)(sb.GT + ((size_t)((b * 4 + h) * 2 + dir) * NCH + c) * 4096 + t * 64 + s0) = *(const LAS u4v*)(Tout + dir * 64 * 72 + t * 72 + s0); }
    LDS_BARRIER();
}

__device__ __forceinline__ void scan_mlstm(const ScanBufs& sb, LAS unsigned char* lds, int b, int h, int dir, int hf) {
    const int tid0 = threadIdx.x, wave = __builtin_amdgcn_readfirstlane(tid0 >> 6);
    LAS bf16* Qs0 = (LAS bf16*)lds; LAS bf16* QKD0 = Qs0 + 2 * 4608; LAS bf16* KTW0 = QKD0 + 2 * 4608; LAS bf16* VT0 = KTW0 + 2 * 4608; LAS bf16* CT0 = VT0 + 2 * 4608;
    LAS float* SC0 = (LAS float*)(CT0 + 2 * 4608);
    LAS float* NV0 = SC0 + 3 * MSCN;
    LAS float* DEN0 = NV0 + 128;
    const int rt = wave >> 1;
    const size_t seq = (size_t)(b * 4 + h), dseq = seq * 2 + dir;
    struct Regs { u4v rq, rk, rqk, rv; f32x4 rsc; };
    Regs R0, R1; R0.rsc = (f32x4){0.f, 0.f, 0.f, 0.f}; R1.rsc = R0.rsc;
    auto chunk_of = [&](int ci) { return ci < 4 ? (dir ? 3 - ci : ci) : (dir ? NCH + 3 - ci : ci); };
    auto prefetch = [&](Regs& R, int ci) {
        const int tid = opaque(tid0), lane = tid & 63, fq = lane >> 4, fr = lane & 15, r = tid >> 3, c0 = (tid & 7) * 8; (void)fq; (void)fr; (void)r; (void)c0; (void)lane;
        if (ci >= NCH) return;
        const int c = chunk_of(ci); const size_t it = seq * NCH + c;
        R.rq = *(const u4v*)(sb.MQ + it * 4096 + r * 64 + c0); R.rk = *(const u4v*)(sb.MKT + it * 4096 + r * 64 + c0);
        R.rqk = *(const u4v*)(sb.MQK + it * 4096 + r * 64 + c0); R.rv = *(const u4v*)(sb.MVT + it * 8192 + (hf * 64 + r) * 64 + c0);
        if (tid < MSCN / 4) R.rsc = *(const f32x4*)(sb.MSC + (dseq * NCH + c) * MSCN + tid * 4);
    };
    auto put_sc = [&](const Regs& R, int ci) { const int tid = opaque(tid0); if (ci < NCH && tid < MSCN / 4) *(LAS f32x4*)(SC0 + (ci % 3) * MSCN + tid * 4) = R.rsc; };
    auto put_tiles = [&](const Regs& R, int ci) {
        const int tid = opaque(tid0), lane = tid & 63, fq = lane >> 4, fr = lane & 15, r = tid >> 3, c0 = (tid & 7) * 8; (void)fq; (void)fr; (void)r; (void)c0; (void)lane;
        if (ci >= NCH) return;
        const int p = ci & 1; const LAS float* SC = SC0 + (ci % 3) * MSCN;
        *(LAS u4v*)(Qs0 + p * 4608 + r * 72 + c0) = R.rq; *(LAS u4v*)(VT0 + p * 4608 + r * 72 + c0) = R.rv;
        float f[8], g[8], bs[8], is_[8], wsv[8]; unpack8(R.rqk, f); unpack8(R.rk, g); const float bt = SC[r];
        lds8(SC + c0, bs); lds8(SC + 64 + c0, is_); lds8(SC + 128 + c0, wsv);
#pragma unroll
        for (int e = 0; e < 8; ++e) { const int s = c0 + e; const bool le = dir ? (s >= r) : (s <= r);
            const float ex = __expf(le ? bt - bs[e] + is_[e] : 0.f); f[e] = le ? f[e] * ex : 0.f; g[e] *= wsv[e]; }
        *(LAS u4v*)(QKD0 + p * 4608 + r * 72 + c0) = pack8(f); *(LAS u4v*)(KTW0 + p * 4608 + r * 72 + c0) = pack8(g);
    };
    prefetch(R0, 0); prefetch(R1, 1);
    for (int i = tid0; i < 2 * 4608 / 2; i += NTHR) ((LAS unsigned*)CT0)[i] = 0u;
    if (tid0 < 128) NV0[tid0] = 0.f;
    put_sc(R0, 0); put_sc(R1, 1);
    LDS_BARRIER();
    put_tiles(R0, 0); prefetch(R0, 2);
    LDS_BARRIER();
    f32x4 Cacc[2] = {{0.f, 0.f, 0.f, 0.f}, {0.f, 0.f, 0.f, 0.f}};
    f32x4 oacc[2] = {{0.f, 0.f, 0.f, 0.f}, {0.f, 0.f, 0.f, 0.f}};
    int cprev = -1;
    auto step = [&](const int ci, Regs& Ra, Regs& Rb) {
        const int tid = opaque(tid0), lane = tid & 63, fq = lane >> 4, fr = lane & 15, r = tid >> 3, c0 = (tid & 7) * 8; (void)fq; (void)fr; (void)r; (void)c0; (void)lane;
        const int c = chunk_of(ci), p = ci & 1; const bool lat = c >= 4;
        const LAS float* SC = SC0 + (ci % 3) * MSCN;
        if (cprev >= 4) {
#pragma unroll
            for (int cc = 0; cc < 2; ++cc) { const int ct = 2 * (wave & 1) + cc, t = 16 * ct + fr; const float sc = 1.f / fmaxf(fabsf(DEN0[(p ^ 1) * 64 + t]), 1.f);
                const size_t row = (size_t)dir * T + chunk_row(b, cprev, t, false);
                *(u2v*)(sb.HML + row * 512 + h * 128 + hf * 64 + 16 * rt + 4 * fq) = mk2(pk2(oacc[cc][0] * sc, oacc[cc][1] * sc), pk2(oacc[cc][2] * sc, oacc[cc][3] * sc)); }
        }
        put_tiles(Ra, ci + 1); put_sc(Rb, ci + 2);
        prefetch(Ra, ci + 3);
        const LAS bf16* Qs = Qs0 + p * 4608; const LAS bf16* QKD = QKD0 + p * 4608; const LAS bf16* KTW = KTW0 + p * 4608; const LAS bf16* VT = VT0 + p * 4608;
        const float ebend = SC[320];
        if (lat) {
            { float f[8], nv[8]; float dot = 0.f; const u4v qq = *(const LAS u4v*)(Qs + r * 72 + c0); unpack8(qq, f); lds8(NV0 + p * 64 + c0, nv);
#pragma unroll
              for (int e = 0; e < 8; ++e) dot += f[e] * nv[e];
              dot += dpp_f<0xB1>(dot); dot += dpp_f<0x4E>(dot); dot += dpp_f<0x141>(dot);
              if ((tid & 7) == 0) DEN0[p * 64 + r] = SC[192 + r] + __expf(SC[r]) * dot; }
            bf16x8 cf[2], vf[2], qfr[2][2], df[2][2]; float eb[2];
#pragma unroll
            for (int ks = 0; ks < 2; ++ks) { cf[ks] = ldfrag(CT0 + p * 4608, 72, 16 * rt, 32 * ks, lane); vf[ks] = ldfrag(VT, 72, 16 * rt, 32 * ks, lane); }
#pragma unroll
            for (int cc = 0; cc < 2; ++cc) { const int ct = 2 * (wave & 1) + cc; eb[cc] = __expf(SC[16 * ct + fr]);
#pragma unroll
                for (int ks = 0; ks < 2; ++ks) { qfr[cc][ks] = ldfrag(Qs, 72, 16 * ct, 32 * ks, lane); df[cc][ks] = ldfrag(QKD, 72, 16 * ct, 32 * ks, lane); } }
#pragma unroll
            for (int cc = 0; cc < 2; ++cc) { oacc[cc] = (f32x4){0.f, 0.f, 0.f, 0.f};
#pragma unroll
                for (int ks = 0; ks < 2; ++ks) oacc[cc] = MFMA16(cf[ks], qfr[cc][ks], oacc[cc]); }
#pragma unroll
            for (int cc = 0; cc < 2; ++cc) {
#pragma unroll
                for (int j = 0; j < 4; ++j) oacc[cc][j] *= eb[cc];
#pragma unroll
                for (int ks = 0; ks < 2; ++ks) oacc[cc] = MFMA16(vf[ks], df[cc][ks], oacc[cc]); }
        }
        { bf16x8 kf[2], vf2[2][2];
#pragma unroll
          for (int ks = 0; ks < 2; ++ks) { kf[ks] = ldfrag(KTW, 72, 16 * rt, 32 * ks, lane);
#pragma unroll
              for (int cc = 0; cc < 2; ++cc) vf2[cc][ks] = ldfrag(VT, 72, 16 * (2 * (wave & 1) + cc), 32 * ks, lane); }
#pragma unroll
          for (int cc = 0; cc < 2; ++cc) {
#pragma unroll
              for (int j = 0; j < 4; ++j) Cacc[cc][j] *= ebend;
#pragma unroll
              for (int ks = 0; ks < 2; ++ks) Cacc[cc] = MFMA16(kf[ks], vf2[cc][ks], Cacc[cc]); } }
#pragma unroll
        for (int cc = 0; cc < 2; ++cc) { const int vt = 2 * (wave & 1) + cc;
            *(LAS u2v*)(CT0 + (p ^ 1) * 4608 + (16 * vt + fr) * 72 + 16 * rt + 4 * fq) = mk2(pk2(Cacc[cc][0], Cacc[cc][1]), pk2(Cacc[cc][2], Cacc[cc][3])); }
        if (tid < 64) NV0[(p ^ 1) * 64 + tid] = ebend * NV0[p * 64 + tid] + SC[256 + tid];
        cprev = c;
        LDS_BARRIER();
    };
    for (int ci = 0; ci < NCH; ci += 2) { step(ci, R1, R0); step(ci + 1, R0, R1); }
    if (cprev >= 4) {
        const int tid = opaque(tid0), lane = tid & 63, fq = lane >> 4, fr = lane & 15, r = tid >> 3, c0 = (tid & 7) * 8; (void)fq; (void)fr; (void)r; (void)c0; (void)lane;
#pragma unroll
        for (int cc = 0; cc < 2; ++cc) { const int ct = 2 * (wave & 1) + cc, t = 16 * ct + fr; const float sc = 1.f / fmaxf(fabsf(DEN0[((NCH - 1) & 1) * 64 + t]), 1.f);
            const size_t row = (size_t)dir * T + chunk_row(b, cprev, t, false);
            *(u2v*)(sb.HML + row * 512 + h * 128 + hf * 64 + 16 * rt + 4 * fq) = mk2(pk2(oacc[cc][0] * sc, oacc[cc][1] * sc), pk2(oacc[cc][2] * sc, oacc[cc][3] * sc)); }
    }
    LDS_BARRIER();
}

__device__ __forceinline__ void scan_gdn(const ScanBufs& sb, LAS unsigned char* lds, int b, int h, int dir, int hf) {
    const int tid0 = threadIdx.x, wave = __builtin_amdgcn_readfirstlane(tid0 >> 6);
    LAS bf16* KT0 = (LAS bf16*)lds;
    LAS bf16* QKD0 = (LAS bf16*)(lds + 36864);
    LAS bf16* VT = (LAS bf16*)(lds + 55296);
    LAS bf16* T1 = (LAS bf16*)(lds + 64512);
    LAS bf16* T2 = (LAS bf16*)(lds + 73728);
    LAS bf16* Wn = (LAS bf16*)(lds + 82944);
    LAS bf16* ST0 = (LAS bf16*)(lds + 100352);
    LAS bf16* VNT = (LAS bf16*)(lds + 135168);
    LAS bf16* VNS = (LAS bf16*)(lds + 144384);
    LAS float* SC0 = (LAS float*)(lds + 153600);
    const int tt2 = wave >> 1;
    const size_t seq = (size_t)(b * 4 + h), dseq = seq * 2 + dir;
    struct Regs { u4v rkt[2], rv, rqk, rtt; f32x4 rsc; u4v dum[2]; };
    Regs R0, R1; R0.rsc = (f32x4){0.f, 0.f, 0.f, 0.f}; R1.rsc = R0.rsc;
    auto chunk_of = [&](int ci) { return ci < 4 ? (dir ? 3 - ci : ci) : (dir ? NCH + 3 - ci : ci); };
    auto prefetch = [&](Regs& R, int ci) {
        const int tid = opaque(tid0), lane = tid & 63, fq = lane >> 4, fr = lane & 15, r = tid >> 3, c0 = (tid & 7) * 8; (void)fq; (void)fr; (void)r; (void)c0; (void)lane;
        if (ci >= NCH) return;
        const int c = chunk_of(ci); const size_t it = seq * NCH + c;
#pragma unroll
        for (int i = 0; i < 2; ++i) { const int idx = tid + i * NTHR; R.rkt[i] = *(const u4v*)(sb.GKT + it * 8192 + (idx >> 3) * 64 + (idx & 7) * 8); }
        R.rv = *(const u4v*)(sb.GVT + it * 8192 + (hf * 64 + r) * 64 + c0); R.rqk = *(const u4v*)(sb.GQK + it * 4096 + r * 64 + c0);
        R.rtt = *(const u4v*)(sb.GT + (dseq * NCH + c) * 4096 + r * 64 + c0);
#if SCAN_DBL == 51
#pragma unroll
        for (int i = 0; i < 2; ++i) { const int idx = tid + i * NTHR; R.dum[i] = *(const u4v*)(sb.GQ + it * 8192 + (idx >> 4) * 128 + (idx & 15) * 8); }
#endif
        if (tid < GSCN / 4) R.rsc = *(const f32x4*)(sb.GSC + (dseq * NCH + c) * GSCN + tid * 4);
    };
    auto put_sc = [&](const Regs& R, int ci) { const int tid = opaque(tid0); if (ci < NCH && tid < GSCN / 4) *(LAS f32x4*)(SC0 + (ci % 3) * GSCN + tid * 4) = R.rsc; };
    auto put_tiles = [&](const Regs& R, int ci) {
        const int tid = opaque(tid0), lane = tid & 63, fq = lane >> 4, fr = lane & 15, r = tid >> 3, c0 = (tid & 7) * 8; (void)fq; (void)fr; (void)r; (void)c0; (void)lane;
        if (ci >= NCH) return;
        const int p = ci & 1; const LAS float* SC = SC0 + (ci % 3) * GSCN;
#pragma unroll
        for (int i = 0; i < 2; ++i) { const int idx = tid + i * NTHR; *(LAS u4v*)(KT0 + p * 9216 + (idx >> 3) * 72 + (idx & 7) * 8) = R.rkt[i]; }
        *(LAS u4v*)(VT + r * 72 + c0) = R.rv;
#if SCAN_DBL == 51
        asm volatile("" :: "v"(R.dum[0]), "v"(R.dum[1]));
#endif
        float f[8], g[8], g2[8], Gs[8], bg[8], be[8]; unpack8(R.rqk, f); unpack8(R.rtt, g); const float Gt = SC[r];
        lds8(SC + c0, Gs); lds8(SC + 64 + c0, bg); lds8(SC + 128 + c0, be);
#pragma unroll
        for (int e = 0; e < 8; ++e) { const int s = c0 + e; const bool le = dir ? (s >= r) : (s <= r);
            const float ex = __expf(le ? Gt - Gs[e] : 0.f); f[e] = le ? f[e] * ex : 0.f; g2[e] = g[e] * be[e]; g[e] *= bg[e]; }
        *(LAS u4v*)(QKD0 + p * 4608 + r * 72 + c0) = pack8(f); *(LAS u4v*)(T1 + r * 72 + c0) = pack8(g); *(LAS u4v*)(T2 + r * 72 + c0) = pack8(g2);
    };
    f32x4 vacc[2];
    auto s1s2 = [&](int ci) {
        const int tid = opaque(tid0), lane = tid & 63, fq = lane >> 4, fr = lane & 15, r = tid >> 3, c0 = (tid & 7) * 8; (void)fq; (void)fr; (void)r; (void)c0; (void)lane;
        if (ci >= NCH) return;
        const LAS bf16* KT = KT0 + (ci & 1) * 9216;
        bf16x8 kf[2], t1f[4][2], t2f[2], vf[2][2];
#pragma unroll
        for (int ks = 0; ks < 2; ++ks) { kf[ks] = ldfrag(KT, 72, 16 * wave, 32 * ks, lane); t2f[ks] = ldfrag(T2, 72, 16 * tt2, 32 * ks, lane);
#pragma unroll
            for (int tt = 0; tt < 4; ++tt) t1f[tt][ks] = ldfrag(T1, 72, 16 * tt, 32 * ks, lane);
#pragma unroll
            for (int cc = 0; cc < 2; ++cc) vf[cc][ks] = ldfrag(VT, 72, 16 * (2 * (wave & 1) + cc), 32 * ks, lane); }
        f32x4 wacc[4];
#pragma unroll
        for (int tt = 0; tt < 4; ++tt) { wacc[tt] = (f32x4){0.f, 0.f, 0.f, 0.f};
#pragma unroll
            for (int ks = 0; ks < 2; ++ks) wacc[tt] = MFMA16(kf[ks], t1f[tt][ks], wacc[tt]); }
#pragma unroll
        for (int cc = 0; cc < 2; ++cc) { vacc[cc] = (f32x4){0.f, 0.f, 0.f, 0.f};
#pragma unroll
            for (int ks = 0; ks < 2; ++ks) vacc[cc] = MFMA16(t2f[ks], vf[cc][ks], vacc[cc]); }
#pragma unroll
        for (int tt = 0; tt < 4; ++tt) *(LAS u2v*)(Wn + (16 * tt + fr) * 136 + 16 * wave + 4 * fq) = mk2(pk2(-wacc[tt][0], -wacc[tt][1]), pk2(-wacc[tt][2], -wacc[tt][3]));
    };
    prefetch(R0, 0); prefetch(R1, 1);
    for (int i = tid0; i < 2 * 64 * 136 / 2; i += NTHR) ((LAS unsigned*)ST0)[i] = 0u;
    put_sc(R0, 0); put_sc(R1, 1);
    LDS_BARRIER();
    put_tiles(R0, 0); prefetch(R0, 2);
    LDS_BARRIER();
    s1s2(0);
    f32x4 Sacc[4];
#pragma unroll
    for (int i = 0; i < 4; ++i) Sacc[i] = (f32x4){0.f, 0.f, 0.f, 0.f};
    LDS_BARRIER();
    auto load_qf = [&](u4v (&qf)[4], int ci) {
        if (ci >= NCH) return;
        const int lane = opaque(tid0) & 63, fq = lane >> 4, fr = lane & 15;
        const bf16* gq = sb.GQ + (seq * NCH + chunk_of(ci)) * 8192;
#pragma unroll
        for (int ks = 0; ks < 4; ++ks) qf[ks] = *(const u4v*)(gq + (16 * (wave >> 1) + fr) * 128 + 32 * ks + 8 * fq); };
    u4v qfn[4];
    auto step = [&](const int ci, Regs& Ra, Regs& Rb) {
        const int tid = opaque(tid0), lane = tid & 63, fq = lane >> 4, fr = lane & 15, r = tid >> 3, c0 = (tid & 7) * 8; (void)fq; (void)fr; (void)r; (void)c0; (void)lane;
        const int c = chunk_of(ci), p = ci & 1; const bool lat = c >= 4;
        const LAS float* SC = SC0 + (ci % 3) * GSCN;
        put_tiles(Ra, ci + 1); put_sc(Rb, ci + 2);
        u4v qf[4];
#pragma unroll
        for (int ks = 0; ks < 4; ++ks) { qf[ks] = qfn[ks]; asm volatile("" : "+v"(qf[ks])); }
        prefetch(Ra, ci + 3); load_qf(qfn, ci + 1);
        const LAS bf16* ST = ST0 + p * 8704; const LAS bf16* KT = KT0 + p * 9216; const LAS bf16* QKD = QKD0 + p * 4608;
        bf16x8 sf[2][4];
        { bf16x8 wf[4];
#pragma unroll
          for (int ks = 0; ks < 4; ++ks) { wf[ks] = ldfrag(Wn, 136, 16 * tt2, 32 * ks, lane);
#pragma unroll
              for (int cc = 0; cc < 2; ++cc) sf[cc][ks] = ldfrag(ST, 136, 16 * (2 * (wave & 1) + cc), 32 * ks, lane); }
          const int tb = 16 * tt2 + 4 * fq; const f32x4 ege = *(const LAS f32x4*)(SC + 192 + tb);
#pragma unroll
          for (int ks = 0; ks < 4; ++ks)
#pragma unroll
              for (int cc = 0; cc < 2; ++cc) vacc[cc] = MFMA16(wf[ks], sf[cc][ks], vacc[cc]);
#pragma unroll
          for (int cc = 0; cc < 2; ++cc) { const int dvt = 2 * (wave & 1) + cc;
              *(LAS u2v*)(VNT + (16 * dvt + fr) * 72 + tb) = mk2(pk2(vacc[cc][0], vacc[cc][1]), pk2(vacc[cc][2], vacc[cc][3]));
              *(LAS u2v*)(VNS + (16 * dvt + fr) * 72 + tb) = mk2(pk2(vacc[cc][0] * ege[0], vacc[cc][1] * ege[1]), pk2(vacc[cc][2] * ege[2], vacc[cc][3] * ege[3])); } }
        LDS_BARRIER();
        const float egend = SC[256];
        { bf16x8 kf[2], nf[4][2];
#pragma unroll
          for (int ks = 0; ks < 2; ++ks) { kf[ks] = ldfrag(KT, 72, 16 * wave, 32 * ks, lane);
#pragma unroll
              for (int dvt = 0; dvt < 4; ++dvt) nf[dvt][ks] = ldfrag(VNS, 72, 16 * dvt, 32 * ks, lane); }
#pragma unroll
          for (int dvt = 0; dvt < 4; ++dvt) {
#pragma unroll
              for (int j = 0; j < 4; ++j) Sacc[dvt][j] *= egend;
#pragma unroll
              for (int ks = 0; ks < 2; ++ks) Sacc[dvt] = MFMA16(kf[ks], nf[dvt][ks], Sacc[dvt]); } }
#pragma unroll
        for (int dvt = 0; dvt < 4; ++dvt) {
            *(LAS u2v*)(ST0 + (p ^ 1) * 8704 + (16 * dvt + fr) * 136 + 16 * wave + 4 * fq) = mk2(pk2(Sacc[dvt][0], Sacc[dvt][1]), pk2(Sacc[dvt][2], Sacc[dvt][3])); }
        if (lat) {
            const int tt = wave >> 1, t = 16 * tt + fr;
            bf16x8 nf4[2][2], df4[2], qb[4];
#pragma unroll
            for (int ks = 0; ks < 4; ++ks) __builtin_memcpy(&qb[ks], &qf[ks], 16);
#pragma unroll
            for (int ks = 0; ks < 2; ++ks) { df4[ks] = ldfrag(QKD, 72, 16 * tt, 32 * ks, lane);
#pragma unroll
                for (int cc = 0; cc < 2; ++cc) nf4[cc][ks] = ldfrag(VNT, 72, 16 * (2 * (wave & 1) + cc), 32 * ks, lane); }
            const float eg = __expf(SC[t]);
            f32x4 acc[2] = {{0.f, 0.f, 0.f, 0.f}, {0.f, 0.f, 0.f, 0.f}};
#pragma unroll
            for (int ks = 0; ks < 4; ++ks)
#pragma unroll
                for (int cc = 0; cc < 2; ++cc) acc[cc] = MFMA16(sf[cc][ks], qb[ks], acc[cc]);
#pragma unroll
            for (int cc = 0; cc < 2; ++cc) {
#pragma unroll
                for (int j = 0; j < 4; ++j) acc[cc][j] *= eg;
#pragma unroll
                for (int ks = 0; ks < 2; ++ks) acc[cc] = MFMA16(nf4[cc][ks], df4[ks], acc[cc]); }
            const size_t row = (size_t)dir * T + chunk_row(b, c, t, true); const float qs = 0.08838834764831845f;
#pragma unroll
            for (int cc = 0; cc < 2; ++cc) { const int dvt = 2 * (wave & 1) + cc;
                *(u2v*)(sb.OGD + row * 512 + h * 128 + hf * 64 + 16 * dvt + 4 * fq) = mk2(pk2(acc[cc][0] * qs, acc[cc][1] * qs), pk2(acc[cc][2] * qs, acc[cc][3] * qs)); }
        }
        s1s2(ci + 1);
        LDS_BARRIER();
    };
    load_qf(qfn, 0);
    for (int ci = 0; ci < NCH; ci += 2) { step(ci, R1, R0); step(ci + 1, R0, R1); }
    LDS_BARRIER();
}

__global__ void __launch_bounds__(NTHR, 2) fwd(Args args) {
    extern __shared__ __attribute__((aligned(16))) unsigned char lds_raw[];
    LAS unsigned char* lds = (LAS unsigned char*)lds_raw;
    int tid = threadIdx.x, lane = tid & 63; const int wave = __builtin_amdgcn_readfirstlane(tid >> 6);
#define OPQ() asm volatile("" : "+v"(tid), "+v"(lane))
    const int G = gridDim.x, bid = blockIdx.x;
    const int gw = bid * NWAVE + wave, NGW = G * NWAVE;
    unsigned char* ws = args.ws;
    unsigned* ctl = (unsigned*)(ws + WS_CTL);
    float* MOD = (float*)(ws + WS_MOD);
    int* IDX = (int*)(ws + WS_IDX); float* GWT = (float*)(ws + WS_GWT); int* WCNT = (int*)(ws + WS_WCNT);
    int* LTOK = (int*)(ws + WS_LTOK); float* LW = (float*)(ws + WS_LW);
    int* TE = (int*)(ws + WS_TE);
    float* GATES = (float*)(ws + WS_GATES);
    bf16* WINT = (bf16*)(ws + WS_WINT); bf16* WOUTT = (bf16*)(ws + WS_WOUTT); unsigned char* WSGU8 = ws + WS_WSGU8; unsigned char* WSD8 = ws + WS_WSD8;
    unsigned char* WGU8 = ws + WS_WGU8; unsigned char* WD8 = ws + WS_WD8; unsigned char* HF8 = ws + WS_HF8;
    bf16* H = (bf16*)(ws + WS_H); bf16* PQK = (bf16*)(ws + WS_PQK); bf16* PV = (bf16*)(ws + WS_PV); bf16* PO = (bf16*)(ws + WS_PO);
    bf16* RAW = (bf16*)(ws + WS_RAW); bf16* PZ = (bf16*)(ws + WS_PZ); bf16* QKVP = (bf16*)(ws + WS_QKVP);
    ScanBufs sbf;
    sbf.PQK = PQK; sbf.PV = PV; sbf.RAW = RAW; sbf.GATES = GATES;
    sbf.MQ = (bf16*)(ws + WS_MQ); sbf.MKT = (bf16*)(ws + WS_MKT); sbf.MQK = (bf16*)(ws + WS_MQK); sbf.MVT = (bf16*)(ws + WS_MVT); sbf.MSC = (float*)(ws + WS_MSC);
    sbf.GQ = (bf16*)(ws + WS_GQ); sbf.GKT = (bf16*)(ws + WS_GKT); sbf.GVT = (bf16*)(ws + WS_GVT); sbf.GQK = (bf16*)(ws + WS_GQK); sbf.GT = (bf16*)(ws + WS_GT); sbf.GSC = (float*)(ws + WS_GSC);
    sbf.HML = (bf16*)(ws + WS_HML); sbf.OGD = (bf16*)(ws + WS_OGD);
    sbf.ib = args.in[I_MLIB]; sbf.fb = args.in[I_MLFB]; sbf.cw = args.in[I_GDCW]; sbf.alog = args.in[I_GDAL]; sbf.dtb = args.in[I_GDDT];
    bf16* HML = (bf16*)(ws + WS_HML); bf16* OGD = (bf16*)(ws + WS_OGD); bf16* YMIX = (bf16*)(ws + WS_YMIX); bf16* YLAT = (bf16*)(ws + WS_YLAT);
    bf16* HFFN = (bf16*)(ws + WS_HFFN); float* LOGH = (float*)(ws + WS_LOGH); float* LOGL = (float*)(ws + WS_LOGL); bf16* RWT = (bf16*)(ws + WS_RWT); unsigned char* CONTRIB = ws + WS_CONTRIB; int* LDST = (int*)(ws + WS_LDST);
    unsigned char* HBS8 = ws + WS_HBS8; unsigned char* HB8 = ws + WS_HB8; bf16* X1B = (bf16*)(ws + WS_X1B);
    const float* x = args.in[I_X]; float* out = args.out;

    volatile LAS unsigned* MISC = (volatile LAS unsigned*)(lds + 163840 - 256);
    if (tid < 16) MISC[tid] = 0u;
    __syncthreads();
    XcdBarrier bar; bar.bar = ctl + CW_BAR; bar.x = 0; bar.st = nullptr;
    if (N_LAUNCH_MODE == 1) bar = xcd_barrier_post(ctl + CW_BAR, MISC + 8);
    const int lo = args.ph_lo, hi = args.ph_hi;
#define IN(k) (lo <= (k) && (k) < hi)
#define REPS(k) ((k) == REP_PHASE ? REP_N : 1)
#define SEAM(k) do { if (N_LAUNCH_MODE == 1 && IN(k) && IN((k) + 1)) xcd_barrier(bar); } while (0)
    const bool own = (G == T / 256);
    const int ot0 = own ? 256 * bid + wave : gw, ots = own ? NWAVE : NGW, otend = own ? 256 * bid + 256 : T;
#define SEAM_OWN(k) do { if (own) __syncthreads(); else SEAM(k); } while (0)

    for (int _rep = 0; _rep < (IN(0) ? REPS(0) : 0); ++_rep) {
        LAS float* sc = (LAS float*)lds;
        LAS float* part = sc + 9 * 1024;
        const float* c = args.in[I_C]; const float* cctx = args.in[I_CCTX]; const float* wada = args.in[I_WADA]; const float* bada = args.in[I_BADA];
        for (int i = tid; i < 9 * 1024; i += NTHR) { const float v = (i < 8 * 1024) ? c[i] : cctx[i - 8 * 1024]; sc[i] = siluf_(v); }
        __syncthreads();
        for (int it = bid; it < 192; it += G) {
            const int cl = lane & 31, kpar = lane >> 5, col = it * 32 + cl;
            float acc[9];
#pragma unroll
            for (int r = 0; r < 9; ++r) acc[r] = 0.f;
#pragma unroll 16
            for (int j = 0; j < 64; ++j) {
                const int k = wave * 128 + 2 * j + kpar;
                const float w = wada[(size_t)k * 6144 + col];
#pragma unroll
                for (int r = 0; r < 9; ++r) acc[r] += sc[r * 1024 + k] * w;
            }
#pragma unroll
            for (int r = 0; r < 9; ++r) { acc[r] += __shfl_xor(acc[r], 32); if (kpar == 0) part[(wave * 9 + r) * 32 + cl] = acc[r]; }
            __syncthreads();
            for (int i = tid; i < 9 * 32; i += NTHR) {
                const int r = i >> 5, c2 = i & 31; float s = 0.f;
#pragma unroll
                for (int w = 0; w < 8; ++w) s += part[(w * 9 + r) * 32 + c2];
                MOD[r * 6144 + it * 32 + c2] = s + bada[it * 32 + c2];
            }
            __syncthreads();
        }
    }
    SEAM(0);
    OPQ();

    for (int _rep = 0; _rep < (IN(1) ? REPS(1) : 0); ++_rep) {
        {
            LAS float* scr = (LAS float*)(lds + wave * 16384);
            constexpr int I_IN = (D / 64) * (DIN / 32), I_OUT = (D / 64) * (D / 32), I_SG = (D / 64) * (DE / 32), I_SD = (DE / 64) * (D / 32);
            constexpr int N_RWI = (D / 64) * (NE / 32);
            constexpr int NIT = I_IN + I_OUT + 2 * I_SG + I_SD + 2 * N_RWI;
            for (int it = gw; it < NIT; it += NGW) {
                int r = it;
                if (r < I_IN) { transpose_item(args.in[I_WIN], D, DIN, WINT, scr, r, lane, [](int n, int& row, float& sc) {
                        sc = (n >= 256 && n < 512) ? 0.125f : 1.f;
                        row = n < 1536 ? n : n < 1552 ? 3584 + (n - 1536) : n < 3088 ? 1536 + (n - 1552) : n < 3600 ? 3072 + (n - 3088) : n; }); continue; }
                r -= I_IN;
                if (r < I_OUT) { transpose_item(args.in[I_WOUT], D, D, WOUTT, scr, r, lane, [](int n, int& row, float& sc) { sc = 1.f; row = n; }); continue; }
                r -= I_OUT;
                if (r < I_SG) { transpose_item_f8(args.in[I_WSG], D, DE, WSGU8, scr, r, lane, [](int n, int& row, float& sc) { sc = 64.f; row = 256 * (n >> 7) + (n & 127); }); continue; }
                r -= I_SG;
                if (r < I_SG) { transpose_item_f8(args.in[I_WSU], D, DE, WSGU8, scr, r, lane, [](int n, int& row, float& sc) { sc = 64.f; row = 256 * (n >> 7) + 128 + (n & 127); }); continue; }
                r -= I_SG;
                if (r < I_SD) { transpose_item_f8(args.in[I_WSD], DE, D, WSD8, scr, r, lane, [](int n, int& row, float& sc) { sc = 32.f; row = n; }); continue; }
                r -= I_SD;
                if (r < N_RWI) { transpose_item(args.in[I_RW], D, NE, RWT, scr, r, lane, [](int n, int& row, float& sc) { sc = 1.f; row = n; }); continue; }
                r -= N_RWI;
                transpose_item<true>(args.in[I_RW], D, NE, RWT, scr, r, lane, [](int n, int& row, float& sc) { sc = 1.f; row = 256 + n; });
            }
            for (int i = bid * NTHR + tid; i < (3840 - DIN) * D / 8; i += G * NTHR) *(uint4*)(WINT + (size_t)DIN * D + (size_t)i * 8) = make_uint4(0u, 0u, 0u, 0u);
        }
        const float* ctxp = args.in[I_CTX]; const float* wn = args.in[I_NPM];
        struct P1R { f32x4 v[4]; };
        auto p1_load = [&](P1R& R, int row) { const int r = row < TT ? row : gw; const float* src = r < T ? x + (size_t)r * D : ctxp + (size_t)(r - T) * D;
#pragma unroll
            for (int j = 0; j < 4; ++j) R.v[j] = *(const f32x4*)(src + j * 256 + lane * 4); };
        int pb = -1; float pa[16], ps[16];
        auto p1_row = [&](const P1R& R, int row) {
            if (row >= TT) return;
            const int b = row < T ? row / SEQ : 8;
            if (b != pb) { pb = b; const float* md = MOD + b * 6144;
#pragma unroll
                for (int j = 0; j < 4; ++j) { const f32x4 w4 = *(const f32x4*)(wn + j * 256 + lane * 4), s4 = *(const f32x4*)(md + 1024 + j * 256 + lane * 4), h4 = *(const f32x4*)(md + j * 256 + lane * 4);
#pragma unroll
                    for (int e = 0; e < 4; ++e) { pa[j * 4 + e] = w4[e] * (1.f + s4[e]); ps[j * 4 + e] = h4[e]; } } }
            float ss = 0.f;
#pragma unroll
            for (int j = 0; j < 4; ++j) ss += R.v[j].x * R.v[j].x + R.v[j].y * R.v[j].y + R.v[j].z * R.v[j].z + R.v[j].w * R.v[j].w;
            const float rstd = rsqrtf(wave_sum(ss) * (1.f / D) + EPS);
#pragma unroll
            for (int j = 0; j < 4; ++j) {
                const int cb = j * 256 + lane * 4; float o[4];
#pragma unroll
                for (int e = 0; e < 4; ++e) o[e] = R.v[j][e] * rstd * pa[j * 4 + e] + ps[j * 4 + e];
                *(uint2*)(H + (size_t)row * D + cb) = make_uint2((unsigned)f2bf(o[0]) | ((unsigned)f2bf(o[1]) << 16), (unsigned)f2bf(o[2]) | ((unsigned)f2bf(o[3]) << 16));
            } };
        P1R RA, RB; p1_load(RA, gw);
        for (int row = gw; row < TT; row += 2 * NGW) { p1_load(RB, row + NGW); p1_row(RA, row); p1_load(RA, row + 2 * NGW); p1_row(RB, row + NGW); }
    }
    SEAM(1);
    OPQ();

    for (int _rep = 0; _rep < (IN(2) ? REPS(2) : 0); ++_rep) {
        pg::DenseOrder S{(const char*)H, (const char*)WINT, 2 * D, TT / 256, 15, (TT / 256) * 15, G, bid};
        pg::EpiP2 E{PQK, PV, PO, RAW, PZ, GATES};
        pg::gemm_phase<pg::EpiP2, pg::DenseOrder, false>(lds, 2 * D, S, E);
#if REP_GEMM == 2
        pg::gemm_phase<pg::EpiP2, pg::DenseOrder, false>(lds, 2 * D, S, E); pg::gemm_phase<pg::EpiP2, pg::DenseOrder, false>(lds, 2 * D, S, E);
#endif
    }
    SEAM(2);
    OPQ();

    for (int _rep = 0; _rep < (IN(3) ? REPS(3) : 0); ++_rep) {
        constexpr int NIT3 = NB * 4 * NCH;
        if (tid < 32) { const float* srcp = tid < 8 ? sbf.ib : tid < 16 ? sbf.fb : tid < 24 ? sbf.alog : sbf.dtb; ((LAS float*)(lds + 163840 - 512))[tid] = srcp[tid & 7]; }
        __syncthreads();
        {
            PrepMRegs R; int it = bid;
            if (it < NIT3) prep_mlstm_load(sbf, R, it / (4 * NCH), (it / NCH) & 3, it % NCH);
            for (; it < NIT3; it += G) {
                const int nx = it + G;
                prep_mlstm_item(sbf, lds, it / (4 * NCH), (it / NCH) & 3, it % NCH, R, [&]() { if (nx < NIT3) prep_mlstm_load(sbf, R, nx / (4 * NCH), (nx / NCH) & 3, nx % NCH); });
            }
        }
#if SCAN_DBL == 41
        {
            PrepMRegs R; int it = bid;
            if (it < NIT3) prep_mlstm_load(sbf, R, it / (4 * NCH), (it / NCH) & 3, it % NCH);
            for (; it < NIT3; it += G) {
                const int nx = it + G;
                prep_mlstm_item(sbf, lds, it / (4 * NCH), (it / NCH) & 3, it % NCH, R, [&]() { if (nx < NIT3) prep_mlstm_load(sbf, R, nx / (4 * NCH), (nx / NCH) & 3, nx % NCH); });
            }
        }
#endif
        {
            PrepGRegs R; int it = bid;
            if (it < NIT3) prep_gdn_load(sbf, R, it / (4 * NCH), (it / NCH) & 3, it % NCH);
            for (; it < NIT3; it += G) {
                const int nx = it + G;
                prep_gdn_item(sbf, lds, it / (4 * NCH), (it / NCH) & 3, it % NCH, R, [&]() { if (nx < NIT3) prep_gdn_load(sbf, R, nx / (4 * NCH), (nx / NCH) & 3, nx % NCH); });
            }
        }
#if SCAN_DBL == 42
        {
            PrepGRegs R; int it = bid;
            if (it < NIT3) prep_gdn_load(sbf, R, it / (4 * NCH), (it / NCH) & 3, it % NCH);
            for (; it < NIT3; it += G) {
                const int nx = it + G;
                prep_gdn_item(sbf, lds, it / (4 * NCH), (it / NCH) & 3, it % NCH, R, [&]() { if (nx < NIT3) prep_gdn_load(sbf, R, nx / (4 * NCH), (nx / NCH) & 3, nx % NCH); });
            }
        }
#endif
    }
    SEAM(3);
    OPQ();

    for (int _rep = 0; _rep < (IN(4) ? REPS(4) : 0); ++_rep) {
        for (int it = bid; it < 256; it += G) {
            const int hf = (it >> 3) & 1, sq = ((it >> 4) << 3) | (it & 7), kind = sq >> 6, b = (sq >> 3) & 7, h = (sq >> 1) & 3, dir = sq & 1;
            if (kind == 0) { scan_gdn(sbf, lds, b, h, dir, hf);
#if SCAN_DBL == 11
                scan_gdn(sbf, lds, b, h, dir, hf);
#endif
            } else { scan_mlstm(sbf, lds, b, h, dir, hf);
#if SCAN_DBL == 12
                scan_mlstm(sbf, lds, b, h, dir, hf);
#endif
            }
        }
    }
    SEAM(4);
    OPQ();

    for (int _rep = 0; _rep < (IN(5) ? REPS(5) : 0); ++_rep) {
        const float* mlnw = args.in[I_MLNW]; const float* gdnw = args.in[I_GDNW];
        const bool ml = lane < 32; const int c16 = (lane & 31) * 16;
        const float* gp = ml ? mlnw + c16 : gdnw + (c16 & 127);
        float gn[16];
#pragma unroll
        for (int i = 0; i < 4; ++i) { const f32x4 g4 = *(const f32x4*)(gp + 4 * i); gn[4 * i] = g4[0]; gn[4 * i + 1] = g4[1]; gn[4 * i + 2] = g4[2]; gn[4 * i + 3] = g4[3]; }
        struct P5R { u4v l[6]; };
        auto p5_load = [&](P5R& R, int t) { const int tn = t < otend ? t : ot0;
            const bf16* s0 = (ml ? HML : OGD) + (size_t)tn * 512 + c16; const bf16* s1 = s0 + (size_t)T * 512; const bf16* gs = (ml ? PO : PZ) + (size_t)tn * 512 + c16;
            R.l[0] = *(const u4v*)s0; R.l[1] = *(const u4v*)(s0 + 8); R.l[2] = *(const u4v*)s1; R.l[3] = *(const u4v*)(s1 + 8); R.l[4] = *(const u4v*)gs; R.l[5] = *(const u4v*)(gs + 8); };
        auto p5_row = [&](const P5R& R, int t) {
            if (t >= otend) return;
            float v[16], w[16], z[16];
            { float f[8]; unpack8(R.l[0], f);
#pragma unroll
              for (int i = 0; i < 8; ++i) v[i] = f[i];
              unpack8(R.l[1], f);
#pragma unroll
              for (int i = 0; i < 8; ++i) v[8 + i] = f[i];
              unpack8(R.l[2], f);
#pragma unroll
              for (int i = 0; i < 8; ++i) w[i] = f[i];
              unpack8(R.l[3], f);
#pragma unroll
              for (int i = 0; i < 8; ++i) w[8 + i] = f[i];
              unpack8(R.l[4], f);
#pragma unroll
              for (int i = 0; i < 8; ++i) z[i] = f[i];
              unpack8(R.l[5], f);
#pragma unroll
              for (int i = 0; i < 8; ++i) z[8 + i] = f[i]; }
            float ss = 0.f;
#pragma unroll
            for (int i = 0; i < 16; ++i) { v[i] += w[i]; ss += v[i] * v[i]; }
            ss += dpp_f<0xB1>(ss); ss += dpp_f<0x4E>(ss); ss += dpp_f<0x141>(ss);
            const float r = rsqrtf(ss * (1.f / 128.f) + EPS);
            float o[16];
#pragma unroll
            for (int i = 0; i < 16; ++i) { const float act = ml ? sigmoidf_(z[i]) : siluf_(z[i]); o[i] = v[i] * r * gn[i] * act; }
            float o0[8], o1[8];
#pragma unroll
            for (int i = 0; i < 8; ++i) { o0[i] = o[i]; o1[i] = o[8 + i]; }
            *(u4v*)(YMIX + (size_t)t * D + lane * 16) = pack8(o0); *(u4v*)(YMIX + (size_t)t * D + lane * 16 + 8) = pack8(o1); };
        P5R RA, RB; p5_load(RA, ot0);
        for (int t = ot0; t < otend; t += 2 * ots) { p5_load(RB, t + ots); p5_row(RA, t); p5_load(RA, t + 2 * ots); p5_row(RB, t + ots); }
    }
    SEAM_OWN(5);
    OPQ();

    for (int _rep = 0; _rep < (IN(6) ? REPS(6) : 0); ++_rep) {
        pg::DenseOrder S{(const char*)YMIX, (const char*)WOUTT, 2 * D, T / 256, 4, (T / 256) * 4, G, bid, own ? 1 : 0};
        pg::EpiBf16 E{YLAT, D};
        pg::gemm_phase<pg::EpiBf16, pg::DenseOrder, false>(lds, 2 * D, S, E);
#if REP_GEMM == 6
        pg::gemm_phase<pg::EpiBf16, pg::DenseOrder, false>(lds, 2 * D, S, E); pg::gemm_phase<pg::EpiBf16, pg::DenseOrder, false>(lds, 2 * D, S, E);
#endif
    }
    SEAM_OWN(6);
    OPQ();

    for (int _rep = 0; _rep < (IN(7) ? REPS(7) : 0); ++_rep) {
        const float* wq = args.in[I_NQM]; const float* wf = args.in[I_NPF];
        struct P7R { uint2 u[4]; f32x4 xx[4]; };
        auto p7_load = [&](P7R& R, int row) { const int r = row < otend ? row : ot0;
#pragma unroll
            for (int j = 0; j < 4; ++j) { R.u[j] = *(const uint2*)(YLAT + (size_t)r * D + j * 256 + lane * 4); R.xx[j] = *(const f32x4*)(x + (size_t)r * D + j * 256 + lane * 4); } };
        int pb = -1; float pg1[16], pa2[16], ps2[16];
        auto p7_row = [&](const P7R& R, int row) {
            if (row >= otend) return;
            { const int b = row / SEQ;
              if (b != pb) { pb = b; const float* md = MOD + b * 6144;
#pragma unroll
                for (int j = 0; j < 4; ++j) { const int cb = j * 256 + lane * 4;
                    const f32x4 g4 = *(const f32x4*)(md + 2048 + cb), q4 = *(const f32x4*)(wq + cb), f4 = *(const f32x4*)(wf + cb), s4 = *(const f32x4*)(md + 4096 + cb), h4 = *(const f32x4*)(md + 3072 + cb);
#pragma unroll
                    for (int e = 0; e < 4; ++e) { pg1[j * 4 + e] = g4[e] * q4[e]; pa2[j * 4 + e] = f4[e] * (1.f + s4[e]); ps2[j * 4 + e] = h4[e]; } } } }
            float yv[16], xv[16]; float ss = 0.f;
#pragma unroll
            for (int j = 0; j < 4; ++j) { const uint2 u = R.u[j];
                yv[j * 4] = bf2f((bf16)(u.x & 0xffffu)); yv[j * 4 + 1] = bf2f((bf16)(u.x >> 16)); yv[j * 4 + 2] = bf2f((bf16)(u.y & 0xffffu)); yv[j * 4 + 3] = bf2f((bf16)(u.y >> 16)); }
#pragma unroll
            for (int i = 0; i < 16; ++i) ss += yv[i] * yv[i];
            const float r1 = rsqrtf(wave_sum(ss) * (1.f / D) + EPS);
            float s2 = 0.f;
#pragma unroll
            for (int j = 0; j < 4; ++j) { const f32x4 xx = R.xx[j];
#pragma unroll
                for (int e = 0; e < 4; ++e) { const float v = xx[e] + pg1[j * 4 + e] * (yv[j * 4 + e] * r1); xv[j * 4 + e] = v; s2 += v * v; } }
            const float r2 = rsqrtf(wave_sum(s2) * (1.f / D) + EPS);
#pragma unroll
            for (int j = 0; j < 4; ++j) { f32x4 o, hf;
#pragma unroll
                for (int e = 0; e < 4; ++e) { o[e] = xv[j * 4 + e]; hf[e] = xv[j * 4 + e] * r2 * pa2[j * 4 + e] + ps2[j * 4 + e]; }
                *(uint2*)(X1B + (size_t)row * D + j * 256 + lane * 4) = make_uint2((unsigned)f2bf(o[0]) | ((unsigned)f2bf(o[1]) << 16), (unsigned)f2bf(o[2]) | ((unsigned)f2bf(o[3]) << 16));
                *(uint2*)(HFFN + (size_t)row * D + j * 256 + lane * 4) = make_uint2((unsigned)f2bf(hf[0]) | ((unsigned)f2bf(hf[1]) << 16), (unsigned)f2bf(hf[2]) | ((unsigned)f2bf(hf[3]) << 16));
                { int p8 = 0; p8 = __builtin_amdgcn_cvt_pk_fp8_f32(hf[0], hf[1], p8, false); p8 = __builtin_amdgcn_cvt_pk_fp8_f32(hf[2], hf[3], p8, true); *(int*)(HF8 + (size_t)row * D + j * 256 + lane * 4) = p8; } } };
        P7R RA, RB; p7_load(RA, ot0);
        for (int row = ot0; row < otend; row += 2 * ots) { p7_load(RB, row + ots); p7_row(RA, row); p7_load(RA, row + 2 * ots); p7_row(RB, row + ots); }
    }
    SEAM_OWN(7);
    OPQ();

    for (int _rep = 0; _rep < (IN(8) ? REPS(8) : 0); ++_rep) {
        pg::DenseOrder S{(const char*)HFFN, (const char*)RWT, 2 * D, T / 256, ROUTER_LO ? 2 : 1, (T / 256) * (ROUTER_LO ? 2 : 1), G, bid, own ? 1 : 0};
        pg::EpiF32 E{LOGH, LOGL, 256};
        pg::gemm_phase<pg::EpiF32, pg::DenseOrder, false>(lds, 2 * D, S, E);
#if REP_GEMM == 8
        pg::gemm_phase<pg::EpiF32, pg::DenseOrder, false>(lds, 2 * D, S, E); pg::gemm_phase<pg::EpiF32, pg::DenseOrder, false>(lds, 2 * D, S, E);
#endif
    }
    SEAM_OWN(8);
    OPQ();

    for (int _rep = 0; _rep < (IN(9) ? REPS(9) : 0); ++_rep) {
        LAS unsigned* HIST = (LAS unsigned*)lds;
        if (own) { if (tid < NE) HIST[tid] = 0u; __syncthreads(); }
        auto drain_conv = [&]() {
            LAS float* scr = (LAS float*)(lds + 8192 + wave * 17408);
            for (;;) { unsigned c = 0; if (lane == 0) c = atomicAdd(&ctl[CW_CQA], 1u); c = __builtin_amdgcn_readfirstlane(c); if (c >= (unsigned)NCQA) break;
                conv_chunk(args.in[I_WG], args.in[I_WU], args.in[I_WD], WGU8, WD8, scr, 0, (int)c, lane); }
            for (;;) { unsigned c = 0; if (lane == 0) c = atomicAdd(&ctl[CW_CQB], 1u); c = __builtin_amdgcn_readfirstlane(c); if (c >= (unsigned)NCQB) break;
                conv_chunk(args.in[I_WG], args.in[I_WU], args.in[I_WD], WGU8, WD8, scr, 1, (int)c, lane); } };
        if (wave >= 4) drain_conv();
        const float* rb = args.in[I_RB];
        LAS float* selb = (LAS float*)lds + wave * 256;
        struct TKR { f32x4 hi, lo; };
        const int kt0 = own ? 256 * bid + (wave & 3) : bid * 4 + (wave & 3), kts = own ? 4 : G * 4, ktend = own ? 256 * bid + 256 : T;
        auto tk_load = [&](TKR& R, int t) { const int tc = t < ktend ? t : kt0; R.hi = *(const f32x4*)(LOGH + (size_t)tc * 256 + lane * 4); if (ROUTER_LO) R.lo = *(const f32x4*)(LOGL + (size_t)tc * 256 + lane * 4); };
        const f32x4 rb4 = *(const f32x4*)(rb + lane * 4);
        auto tk_tok = [&](const TKR& R, int t) {
            if (t >= ktend) return;
            f32x4 lg = R.hi; if (ROUTER_LO) lg += R.lo;
            float sc[4], sel[4];
#pragma unroll
            for (int e = 0; e < 4; ++e) { sc[e] = sigmoidf_(lg[e]); sel[e] = sc[e] + rb4[e]; }
            float m1 = fmaxf(sel[0], sel[1]), m2 = fminf(sel[0], sel[1]);
#pragma unroll
            for (int e = 2; e < 4; ++e) { const float v = sel[e]; m2 = fmaxf(m2, fminf(m1, v)); m1 = fmaxf(m1, v); }
#pragma unroll
            for (int o = 1; o < 8; o <<= 1) {
                const float o1 = o == 1 ? dpp_f<0xB1>(m1) : o == 2 ? dpp_f<0x4E>(m1) : dpp_f<0x141>(m1), o2 = o == 1 ? dpp_f<0xB1>(m2) : o == 2 ? dpp_f<0x4E>(m2) : dpp_f<0x141>(m2);
                m2 = fmaxf(fminf(m1, o1), fmaxf(m2, o2)); m1 = fmaxf(m1, o1); }
            const float mygs = m1 + m2; const int myg = lane >> 3;
            int rank = 0;
#pragma unroll
            for (int j = 0; j < 8; ++j) { const float o = readlane_f(mygs, j * 8); rank += (o > mygs || (o == mygs && j < myg)) ? 1 : 0; }
            const bool gsel = rank < 4;
#pragma unroll
            for (int e = 0; e < 4; ++e) if (!gsel) sel[e] = -INFINITY;
            float gsum = 0.f; float myw = 0.f; int myi = 0;
#pragma unroll
            for (int r = 0; r < 8; ++r) {
                float bv = sel[0]; int be = 0; float bsl = sc[0];
#pragma unroll
                for (int e = 1; e < 4; ++e) if (sel[e] > bv) { bv = sel[e]; be = e; bsl = sc[e]; }
                const float wm = wave_max_all(bv);
                const unsigned long long mk = __ballot(bv == wm);
                const int srcl = __builtin_amdgcn_readfirstlane((int)__builtin_ctzll(mk));
                const int bi = srcl * 4 + __builtin_amdgcn_readlane(be, srcl); const float bs = __builtin_bit_cast(float, __builtin_amdgcn_readlane(__builtin_bit_cast(int, bsl), srcl));
                gsum += bs; if (lane == r) { myw = bs; myi = bi; }
#pragma unroll
                for (int e = 0; e < 4; ++e) if (bi == lane * 4 + e) sel[e] = -INFINITY;
            }
            if (lane < 8) { IDX[(size_t)t * 8 + lane] = myi; GWT[(size_t)t * 8 + lane] = myw / gsum * 2.5f;
                if (own) __hip_atomic_fetch_add(&HIST[myi], 1u, __ATOMIC_RELAXED, __HIP_MEMORY_SCOPE_WORKGROUP); else atomicAdd(&ctl[CW_CNT + myi], 1u); }
        };
        if (wave < 4) { TKR RA, RB; tk_load(RA, kt0);
            for (int t = kt0; t < ktend; t += 2 * kts) { tk_load(RB, t + kts); tk_tok(RA, t); tk_load(RA, t + 2 * kts); tk_tok(RB, t + kts); } }
        if (wave < 4) drain_conv();
        if (own) { __syncthreads(); if (tid < NE) WCNT[tid * 256 + bid] = (int)HIST[tid]; }
    }
    SEAM(9);
    OPQ();

    for (int _rep = 0; _rep < ((IN(11) && own) ? 1 : 0); ++_rep) {
        LAS unsigned* OFFL = (LAS unsigned*)lds;
        LAS unsigned* WT = OFFL + 520;
        LAS unsigned* CUR = OFFL + 1024;
        LAS unsigned* TOT = OFFL + 1536;
        { const int e2 = tid >> 1, hf = tid & 1; const int* wrow = WCNT + e2 * 256 + hf * 128; unsigned tot = 0, pre = 0;
#pragma unroll 8
          for (int k = 0; k < 32; ++k) { const int4 v = *(const int4*)(wrow + 4 * k); const int w0 = hf * 128 + 4 * k;
              tot += (unsigned)(v.x + v.y + v.z + v.w); pre += (unsigned)((w0 < bid ? v.x : 0) + (w0 + 1 < bid ? v.y : 0) + (w0 + 2 < bid ? v.z : 0) + (w0 + 3 < bid ? v.w : 0)); }
          tot += __shfl_xor(tot, 1); pre += __shfl_xor(pre, 1);
          if (hf == 0) { TOT[e2] = tot; CUR[e2] = pre; } }
        __syncthreads();
        const unsigned cnt = tid < NE ? TOT[tid] : 0u, ntile = (cnt + 255u) >> 8;
        unsigned incl = ntile;
#pragma unroll
        for (int o = 1; o < 64; o <<= 1) { const unsigned v = __shfl_up(incl, o); if (lane >= o) incl += v; }
        if (lane == 63) WT[wave] = incl;
        __syncthreads();
        unsigned base = 0;
#pragma unroll
        for (int w = 0; w < 8; ++w) base += (w < wave) ? WT[w] : 0u;
        const unsigned toff = base + incl - ntile;
        if (tid < NE) { OFFL[tid] = toff * 256u; CUR[tid] += toff * 256u; }
        if (bid == 0 && tid == NE - 1) { const unsigned tt = toff + ntile; ctl[CW_NRT] = tt < (unsigned)(CAPROWS / 256) ? tt : (unsigned)(CAPROWS / 256); }
        __syncthreads();
        if (bid < NE) {
            const unsigned ce = TOT[bid], nte = (ce + 255u) >> 8, offe = OFFL[bid];
            if ((unsigned)tid < nte && offe / 256u + tid < (unsigned)(CAPROWS / 256)) TE[offe / 256u + tid] = bid;
            const unsigned p = ce + tid; if (p < nte * 256u) { const unsigned q = offe + p; if (q < (unsigned)CAPROWS) { LTOK[q] = 0; LW[q] = 0.f; LDST[q] = -1; } }
        }
        for (int j = tid; j < 2048; j += NTHR) {
            const int t = 256 * bid + (j >> 3); const size_t i = (size_t)t * 8 + (j & 7); const int e = IDX[i];
            const unsigned pos = __hip_atomic_fetch_add(&CUR[e], 1u, __ATOMIC_RELAXED, __HIP_MEMORY_SCOPE_WORKGROUP);
            if (pos < (unsigned)CAPROWS) { LTOK[pos] = t; LW[pos] = GWT[i]; LDST[pos] = t * 9 + (j & 7); }
        }
        __syncthreads();
    }
    for (int _rep = 0; _rep < ((IN(11) && !own) ? 1 : 0); ++_rep) {
        LAS unsigned* OFFL = (LAS unsigned*)lds;
        LAS unsigned* WT = OFFL + 520;
        const unsigned cnt = tid < NE ? ctl[CW_CNT + tid] : 0u, ntile = (cnt + 255u) >> 8;
        unsigned incl = ntile;
#pragma unroll
        for (int o = 1; o < 64; o <<= 1) { const unsigned v = __shfl_up(incl, o); if (lane >= o) incl += v; }
        if (lane == 63) WT[wave] = incl;
        __syncthreads();
        unsigned base = 0;
#pragma unroll
        for (int w = 0; w < 8; ++w) base += (w < wave) ? WT[w] : 0u;
        const unsigned toff = base + incl - ntile;
        if (tid < NE) OFFL[tid] = toff * 256u;
        if (bid == 0 && tid < NE) {
            for (unsigned s = 0; s < ntile; ++s) if (toff + s < (unsigned)(CAPROWS / 256)) TE[toff + s] = tid;
            if (tid == NE - 1) { const unsigned tot = toff + ntile; ctl[CW_NRT] = tot < (unsigned)(CAPROWS / 256) ? tot : (unsigned)(CAPROWS / 256); }
            for (unsigned p = cnt; p < ntile * 256u; ++p) { const unsigned q = toff * 256u + p; if (q < (unsigned)CAPROWS) { LTOK[q] = 0; LW[q] = 0.f; LDST[q] = -1; } }
        }
        __syncthreads();
        for (long i = (long)bid * NTHR + tid; i < (long)T * 8; i += (long)G * NTHR) {
            const int t = (int)(i >> 3), e = IDX[i]; const unsigned pos = OFFL[e] + atomicAdd(&ctl[CW_FILL + e], 1u);
            if (pos < (unsigned)CAPROWS) { LTOK[pos] = t; LW[pos] = GWT[i]; LDST[pos] = t * 9 + (int)(i & 7); }
        }
        __syncthreads();
    }
    SEAM(11);
    OPQ();

    for (int _rep = 0; _rep < (IN(12) ? REPS(12) : 0); ++_rep) {
        { LAS int* tel = (LAS int*)(lds + pg::TE_OFF); for (int i = tid; i < CAPROWS / 256; i += NTHR) tel[i] = TE[i]; __syncthreads(); }
        {
            pg::DenseOrder S{(const char*)HF8, (const char*)WSGU8, D, T / 256, 2, (T / 256) * 2, G, bid};
            pg::EpiGU8 E{HBS8};
            pg::gemm_phase<pg::EpiGU8, pg::DenseOrder, false, true>(lds, D, S, E);
#if REP_GEMM == 120
        pg::gemm_phase<pg::EpiGU8, pg::DenseOrder, false, true>(lds, D, S, E); pg::gemm_phase<pg::EpiGU8, pg::DenseOrder, false, true>(lds, D, S, E);
#endif
        }
        {
            const int nrt = (int)ctl[CW_NRT];
            pg::RoutedGuOrder S{(const char*)HF8, (const char*)WGU8, LTOK, (const LAS int*)(lds + pg::TE_OFF), D, nrt * 2, G, bid};
            pg::EpiGU8 E{HB8};
            pg::gemm_phase<pg::EpiGU8, pg::RoutedGuOrder, true, true>(lds, D, S, E);
#if REP_GEMM == 121
        pg::gemm_phase<pg::EpiGU8, pg::RoutedGuOrder, true, true>(lds, D, S, E); pg::gemm_phase<pg::EpiGU8, pg::RoutedGuOrder, true, true>(lds, D, S, E);
#endif
        }
    }
    SEAM(12);
    OPQ();

    if (IN(13)) {
        { LAS int* tel = (LAS int*)(lds + pg::TE_OFF); for (int i = tid; i < CAPROWS / 256; i += NTHR) tel[i] = TE[i]; __syncthreads(); }
        {
            pg::DenseOrder S{(const char*)HBS8, (const char*)WSD8, DE, T / 256, 4, (T / 256) * 4, G, bid};
            pg::EpiContrib<true> E{CONTRIB, nullptr, nullptr};
            pg::gemm_phase<pg::EpiContrib<true>, pg::DenseOrder, false, true>(lds, DE, S, E);
        }
        {
            const int nrt = (int)ctl[CW_NRT];
            pg::RoutedDownOrder S{(const char*)HB8, (const char*)WD8, (const LAS int*)(lds + pg::TE_OFF), DE, 0, nrt * 4, G, bid};
            pg::EpiContrib<false> E{CONTRIB, LDST, LW};
            pg::gemm_phase<pg::EpiContrib<false>, pg::RoutedDownOrder, false, true>(lds, DE, S, E);
#if REP_GEMM == 131
            pg::gemm_phase<pg::EpiContrib<false>, pg::RoutedDownOrder, false, true>(lds, DE, S, E); pg::gemm_phase<pg::EpiContrib<false>, pg::RoutedDownOrder, false, true>(lds, DE, S, E);
#endif
#if REP_GEMM == 132
            { pg::EpiContrib<false, true> E2{CONTRIB, LDST, LW};
              pg::gemm_phase<pg::EpiContrib<false, true>, pg::RoutedDownOrder, false, true>(lds, DE, S, E2); pg::gemm_phase<pg::EpiContrib<false, true>, pg::RoutedDownOrder, false, true>(lds, DE, S, E2); }
#endif
        }
    }
    SEAM(13);
    OPQ();

    if (IN(14)) {
        const float* wq = args.in[I_NQF];
        typedef float f32x2 __attribute__((ext_vector_type(2)));
        struct P14R { u4v cr[9], x1[2]; };
        auto p14_load = [&](P14R& R, int row) { const int r = row < T ? row : gw;
#pragma unroll
            for (int s = 0; s < 9; ++s) R.cr[s] = *(const u4v*)(CONTRIB + ((size_t)r * 9 + s) * 1024 + lane * 16);
            R.x1[0] = *(const u4v*)(X1B + (size_t)r * D + lane * 16); R.x1[1] = *(const u4v*)(X1B + (size_t)r * D + lane * 16 + 8); };
        int pb = -1; float pg[16];
        auto p14_row = [&](const P14R& R, int row) {
            if (row >= T) return;
            { const int b = row / SEQ;
              if (b != pb) { pb = b; const float* md = MOD + b * 6144;
#pragma unroll
                for (int q4 = 0; q4 < 4; ++q4) { const f32x4 g4 = *(const f32x4*)(md + 5120 + lane * 16 + q4 * 4), w4 = *(const f32x4*)(wq + lane * 16 + q4 * 4);
#pragma unroll
                    for (int e = 0; e < 4; ++e) pg[q4 * 4 + e] = g4[e] * w4[e]; } } }
            float y[16];
#pragma unroll
            for (int i = 0; i < 16; ++i) y[i] = 0.f;
#pragma unroll
            for (int s = 0; s < 9; ++s) {
#pragma unroll
                for (int q4 = 0; q4 < 4; ++q4) { const int wd = (int)R.cr[s][q4]; const f32x2 lo = __builtin_amdgcn_cvt_pk_f32_fp8(wd, false), hi = __builtin_amdgcn_cvt_pk_f32_fp8(wd, true);
                    y[q4 * 4] += lo.x; y[q4 * 4 + 1] += lo.y; y[q4 * 4 + 2] += hi.x; y[q4 * 4 + 3] += hi.y; }
            }
            float ss = 0.f;
#pragma unroll
            for (int i = 0; i < 16; ++i) ss += y[i] * y[i];
            const float r1 = rsqrtf(wave_sum(ss) * (1.f / (D * 256.f)) + EPS) * (1.f / 16.f);
            float x1f[16]; { float f[8]; unpack8(R.x1[0], f);
#pragma unroll
              for (int i = 0; i < 8; ++i) x1f[i] = f[i];
              unpack8(R.x1[1], f);
#pragma unroll
              for (int i = 0; i < 8; ++i) x1f[8 + i] = f[i]; }
#pragma unroll
            for (int q4 = 0; q4 < 4; ++q4) { const int cb = lane * 16 + q4 * 4; f32x4 xx = {x1f[q4 * 4], x1f[q4 * 4 + 1], x1f[q4 * 4 + 2], x1f[q4 * 4 + 3]};
#pragma unroll
                for (int e = 0; e < 4; ++e) xx[e] += pg[q4 * 4 + e] * (y[q4 * 4 + e] * r1);
                *(f32x4*)(out + (size_t)row * D + cb) = xx; } };
        P14R RA, RB; p14_load(RA, gw);
        for (int row = gw; row < T; row += 2 * NGW) { p14_load(RB, row + NGW); p14_row(RA, row); p14_load(RA, row + 2 * NGW); p14_row(RB, row + NGW); }
    }
#undef IN
#undef SEAM
}

constexpr int LDS_BYTES = 163840;
extern "C" void kernel_launch(void* const* d_in, const int* in_sizes, int n_in, void* d_out, int out_size, void* d_ws, size_t ws_size, hipStream_t stream) {
    static int grid = 0;
    if (grid == 0) {
        if (n_in != 27 || out_size != T * D || ws_size < WS_END) { fprintf(stderr, "kernel_launch: unexpected shapes n_in %d out %d ws %zu (need %zu)\n", n_in, out_size, ws_size, (size_t)WS_END); grid = -1; return; }
        int dev = 0, cus = 0, per_cu = 0;
        if (hipGetDevice(&dev) != hipSuccess || hipDeviceGetAttribute(&cus, hipDeviceAttributeMultiprocessorCount, dev) != hipSuccess) { grid = -1; return; }
        if (hipFuncSetAttribute((const void*)fwd, hipFuncAttributeMaxDynamicSharedMemorySize, LDS_BYTES) != hipSuccess) { fprintf(stderr, "kernel_launch: hipFuncSetAttribute failed\n"); grid = -1; return; }
        if (hipOccupancyMaxActiveBlocksPerMultiprocessor(&per_cu, (const void*)fwd, NTHR, LDS_BYTES) != hipSuccess || per_cu < 1) fprintf(stderr, "kernel_launch: occupancy query says %d\n", per_cu);
        (void)hipGetLastError();
        grid = cus;
    }
    if (grid < 0) return;
    (void)hipMemsetAsync((char*)d_ws + WS_CTL, 0, CTL_ZERO_BYTES, stream);
    Args a{};
    for (int i = 0; i < 27; ++i) a.in[i] = (const float*)d_in[i];
    a.out = (float*)d_out; a.ws = (unsigned char*)d_ws;
    if (N_LAUNCH_MODE == 1) { a.ph_lo = 0; a.ph_hi = NPHASE; hipLaunchKernelGGL(fwd, dim3(grid), dim3(NTHR), LDS_BYTES, stream, a); }
    else for (int p = 0; p < NPHASE; ++p) { a.ph_lo = p; a.ph_hi = p + 1; hipLaunchKernelGGL(fwd, dim3(grid), dim3(NTHR), LDS_BYTES, stream, a); }
}
```

```cpp
#include <hip/hip_runtime.h>
#include <cstdio>
#include <cstdint>

#ifndef N_LAUNCH_MODE
#define N_LAUNCH_MODE 1
#endif

#ifndef ROUTER_LO
#define ROUTER_LO 1
#endif
#ifndef SCAN_DBL
#define SCAN_DBL 0
#endif
#ifndef REP_GEMM
#define REP_GEMM (-1)
#endif
#ifndef REP_PHASE
#define REP_PHASE (-1)
#define REP_N 1
#endif
#define LAS __attribute__((address_space(3)))
typedef unsigned short bf16;
typedef float f32x4 __attribute__((ext_vector_type(4)));

constexpr int NB = 8, SEQ = 8192, D = 1024, CTXL = 256, GW_ = 64, ROWS = SEQ / GW_;
constexpr int T = NB * SEQ, TC = NB * CTXL, TT = T + TC;
constexpr int DIN = 3616;
constexpr int NE = 256, TOPK = 8, NGRP = 8, DE = 256;
constexpr float EPS = 1e-6f;
constexpr int NTHR = 512, NWAVE = 8;
constexpr int NPHASE = 15;

constexpr size_t MiB = 1u << 20;
constexpr size_t WS_CTL = 0, CTL_ZERO_BYTES = 1 * MiB;
constexpr size_t WS_MOD = 1 * MiB;
constexpr size_t WS_WCNT = 1 * MiB + 512 * 1024;
constexpr size_t WS_IDX = 2 * MiB;
constexpr size_t WS_GWT = 4 * MiB;
constexpr size_t WS_LTOK = 6 * MiB;
constexpr size_t WS_LW = 9 * MiB;
constexpr size_t WS_TE = 12 * MiB;
constexpr size_t WS_LDST = 23 * MiB;
constexpr size_t WS_GATES = 14 * MiB;
constexpr size_t WS_WINT = 23 * MiB;
constexpr size_t WS_WOUTT = 31 * MiB;
constexpr size_t WS_WSGU8 = 33 * MiB;
constexpr size_t WS_WSD8 = 34 * MiB;
constexpr size_t WS_A = 35 * MiB;
constexpr size_t WS_H = WS_A, WS_PQK = WS_A + 132 * MiB, WS_PV = WS_PQK + 66 * MiB, WS_PO = WS_PV + 66 * MiB;
constexpr size_t WS_RAW = WS_PO + 66 * MiB, WS_PZ = WS_RAW + 198 * MiB, WS_QKVP = WS_PZ + 66 * MiB;
constexpr size_t WS_HML = WS_PQK, WS_OGD = WS_RAW, WS_YMIX = WS_H, WS_YLAT = WS_QKVP;
constexpr size_t WS_MQ = WS_H, WS_MKT = WS_H + 33 * MiB, WS_MQK = WS_H + 66 * MiB, WS_MSC = WS_H + 99 * MiB;
constexpr size_t WS_GQ = WS_QKVP, WS_GKT = WS_GQ + 66 * MiB, WS_GVT = WS_GKT + 66 * MiB, WS_GQK = WS_GVT + 66 * MiB;
constexpr size_t WS_GT = WS_GQK + 33 * MiB, WS_GSC = WS_GT + 66 * MiB, WS_MVT = WS_GSC + 9 * MiB;
constexpr size_t WS_RWT = 13 * MiB;
constexpr size_t WS_WD8 = 1001 * MiB;
constexpr size_t WS_WGU8 = 821 * MiB;
constexpr size_t WS_HF8 = 757 * MiB;
constexpr size_t WS_HFFN = WS_YLAT;
constexpr size_t WS_LOGH = WS_PO, WS_LOGL = WS_PZ;
constexpr size_t WS_CONTRIB = 327 * MiB;
constexpr size_t WS_HB8 = 163 * MiB;
constexpr size_t WS_HBS8 = 311 * MiB;
constexpr size_t WS_X1B = 35 * MiB;
constexpr size_t WS_END = 1067 * MiB;
constexpr int CAPROWS = T * 8 + 320 * 256;
constexpr size_t WS_LDST_UNUSED = 0;

constexpr int CW_BAR = 4096;
constexpr int CW_CNT = 16384;
constexpr int CW_FILL = 16384 + 512;
constexpr int CW_OFF = 16384 + 1024;
constexpr int CW_CQA = 16384 + 3072, CW_CQB = 16384 + 3104;
constexpr int NCQA = 4096, NCQB = 2048;
constexpr int CW_NRT = 16384 + 2048;

__device__ __forceinline__ float bf2f(bf16 v) { return __uint_as_float(((unsigned)v) << 16); }
__device__ __forceinline__ bf16 f2bf(float f) { unsigned u = __float_as_uint(f); u += 0x7fffu + ((u >> 16) & 1u); return (bf16)(u >> 16); }
__device__ __forceinline__ float sigmoidf_(float x) { return __builtin_amdgcn_rcpf(1.0f + __expf(-x)); }
__device__ __forceinline__ float siluf_(float x) { return x * __builtin_amdgcn_rcpf(1.0f + __expf(-x)); }
__device__ __forceinline__ float softplusf_(float x) { return x > 20.f ? x : log1pf(__expf(x)); }
template <int CTRL> __device__ __forceinline__ float dpp_f(float v) { return __builtin_bit_cast(float, __builtin_amdgcn_update_dpp(0, __builtin_bit_cast(int, v), CTRL, 0xf, 0xf, false)); }
__device__ __forceinline__ float readlane_f(float v, int l) { return __builtin_bit_cast(float, __builtin_amdgcn_readlane(__builtin_bit_cast(int, v), l)); }
__device__ __forceinline__ float wave_max_all(float v) {
    v = fmaxf(v, dpp_f<0xB1>(v)); v = fmaxf(v, dpp_f<0x4E>(v)); v = fmaxf(v, dpp_f<0x141>(v)); v = fmaxf(v, dpp_f<0x140>(v));
    return fmaxf(fmaxf(readlane_f(v, 0), readlane_f(v, 16)), fmaxf(readlane_f(v, 32), readlane_f(v, 48)));
}
__device__ __forceinline__ int opaque(int x) { asm volatile("" : "+v"(x)); return x; }
__device__ __forceinline__ float wave_sum(float v) {
    v += dpp_f<0xB1>(v); v += dpp_f<0x4E>(v); v += dpp_f<0x141>(v); v += dpp_f<0x140>(v);
    v = (readlane_f(v, 0) + readlane_f(v, 16)) + (readlane_f(v, 32) + readlane_f(v, 48));
    return v;
}

#define XB_TMO      128
#define XB_XCNT(j)  (256  + 64 * (j))
#define XB_XSUB(j)  (1280 + 64 * (j))
#define XB_XGEN(j)  (2304 + 64 * (j))
#define XB_TOP      3328
#define XB_TOPGEN   3392
#define XCD_BAR_WORDS 3456
#define XB_SPIN_CAP (1u << 18)
__device__ __forceinline__ unsigned xb_ld(unsigned* p)              { return __hip_atomic_load(p, __ATOMIC_RELAXED, __HIP_MEMORY_SCOPE_AGENT); }
__device__ __forceinline__ unsigned xb_add(unsigned* p, unsigned v) { return __hip_atomic_fetch_add(p, v, __ATOMIC_RELAXED, __HIP_MEMORY_SCOPE_AGENT); }
__device__ __forceinline__ unsigned xb_xcc_id() { return (unsigned)__builtin_amdgcn_s_getreg((3 << 11) | 20) & 0xFu; }
#define XB_SPIN(cond, bar) do { unsigned _sp = 0; while (cond) { __builtin_amdgcn_s_sleep(1); \
    if ((++_sp & 255u) == 0u) { if (xb_ld(&(bar)[XB_TMO])) break; if (_sp > XB_SPIN_CAP) { atomicAdd(&(bar)[XB_TMO], 1u); break; } } } } while (0)
struct XcdBarrier { unsigned* bar; unsigned x; volatile LAS unsigned* st; };
__device__ __forceinline__ XcdBarrier xcd_barrier_post(unsigned* bar, volatile LAS unsigned* st) {
    XcdBarrier b; b.bar = bar; b.x = xb_xcc_id(); b.st = st;
    if (threadIdx.x == 0) (void)xb_add(&bar[XB_XCNT(b.x)], 1u);
    return b;
}
__device__ __forceinline__ void xcd_barrier_complete(unsigned* bar, unsigned x, unsigned& nloc, unsigned& nx) {
    const unsigned G = gridDim.x * gridDim.y * gridDim.z;
    unsigned sum, cnt, mine, sp = 0u;
    for (;;) {
        sum = 0u; cnt = 0u; mine = 0u;
#pragma unroll
        for (unsigned j = 0; j < 16; ++j) { const unsigned c = xb_ld(&bar[XB_XCNT(j)]); sum += c; cnt += (c > 0u) ? 1u : 0u; mine = (j == x) ? c : mine; }
        if (sum == G) break;
        __builtin_amdgcn_s_sleep(1);
        if ((++sp & 255u) == 0u) { if (xb_ld(&bar[XB_TMO])) break; if (sp > XB_SPIN_CAP) { atomicAdd(&bar[XB_TMO], 1u); break; } }
    }
    nloc = mine > 0u ? mine : 1u; nx = cnt > 0u ? cnt : 1u;
}
__device__ __forceinline__ void xcd_barrier(const XcdBarrier& b) {
    asm volatile("s_waitcnt vmcnt(0)" ::: "memory");
    __syncthreads();
    if (threadIdx.x == 0) {
        unsigned* bar = b.bar;
        __builtin_amdgcn_s_waitcnt(0);
        unsigned nloc = b.st[0], nx = b.st[1];
        if (nloc == 0u) { xcd_barrier_complete(bar, b.x, nloc, nx); b.st[0] = nloc; b.st[1] = nx; }
        const unsigned old = xb_add(&bar[XB_XSUB(b.x)], 1u);
        const unsigned gen = old / nloc;
        if (old + 1u == (gen + 1u) * nloc) {
            __builtin_amdgcn_fence(__ATOMIC_RELEASE, "agent");
            asm volatile("s_waitcnt vmcnt(0)" ::: "memory");
            const unsigned og = xb_add(&bar[XB_TOP], 1u);
            const unsigned tg = og / nx;
            if (og + 1u == (tg + 1u) * nx) xb_add(&bar[XB_TOPGEN], 1u);
            else XB_SPIN(xb_ld(&bar[XB_TOPGEN]) == tg, bar);
            __builtin_amdgcn_fence(__ATOMIC_ACQUIRE, "agent");
            xb_add(&bar[XB_XGEN(b.x)], 1u);
            asm volatile("s_waitcnt vmcnt(0)" ::: "memory");
        } else {
            XB_SPIN(xb_ld(&bar[XB_XGEN(b.x)]) == gen, bar);
            __builtin_amdgcn_fence(__ATOMIC_ACQUIRE, "agent");
            asm volatile("s_waitcnt vmcnt(0)" ::: "memory");
        }
    }
    __syncthreads();
}

struct Args { const float* in[27]; float* out; unsigned char* ws; int ph_lo, ph_hi; };
enum { I_X = 0, I_C, I_CTX, I_CCTX, I_WADA, I_BADA, I_NPM, I_NQM, I_NPF, I_NQF, I_WIN, I_MLIB, I_MLFB, I_MLNW, I_GDCW, I_GDAL, I_GDDT, I_GDNW,
       I_WOUT, I_RW, I_RB, I_WG, I_WU, I_WD, I_WSG, I_WSU, I_WSD };

constexpr int GT = 128, GK = 16, GAP = GT + 4;
template <class AF, class BF, class EF>
__device__ __forceinline__ void ngemm_tile(int m0, int n0, int Mlim, int N, int K, const AF& af, const BF& bf, const EF& ef, LAS float* As, LAS float* Bs) {
    const int tid = opaque((int)threadIdx.x), ty = tid >> 4, tx = tid & 15;
    float acc[4][8];
#pragma unroll
    for (int i = 0; i < 4; ++i)
#pragma unroll
        for (int j = 0; j < 8; ++j) acc[i][j] = 0.f;
    for (int k0 = 0; k0 < K; k0 += GK) {
        float av[4], bv[4];
#pragma unroll
        for (int i = 0; i < 4; ++i) { const int idx = tid + i * NTHR; const int r = idx >> 4, kk = idx & 15; av[i] = (m0 + r < Mlim) ? af(m0 + r, k0 + kk) : 0.f; }
#pragma unroll
        for (int i = 0; i < 4; ++i) { const int idx = tid + i * NTHR; const int kk = idx >> 7, c = idx & 127; bv[i] = (n0 + c < N) ? bf(k0 + kk, n0 + c) : 0.f; }
        __syncthreads();
#pragma unroll
        for (int i = 0; i < 4; ++i) { const int idx = tid + i * NTHR; const int r = idx >> 4, kk = idx & 15; As[kk * GAP + r] = av[i]; }
#pragma unroll
        for (int i = 0; i < 4; ++i) { const int idx = tid + i * NTHR; const int kk = idx >> 7, c = idx & 127; Bs[kk * GT + c] = bv[i]; }
        __syncthreads();
#pragma unroll
        for (int kk = 0; kk < GK; ++kk) {
            const f32x4 a = *(const LAS f32x4*)(As + kk * GAP + ty * 4);
            const f32x4 b0 = *(const LAS f32x4*)(Bs + kk * GT + tx * 8), b1 = *(const LAS f32x4*)(Bs + kk * GT + tx * 8 + 4);
#pragma unroll
            for (int i = 0; i < 4; ++i) {
#pragma unroll
                for (int j = 0; j < 4; ++j) { acc[i][j] += a[i] * b0[j]; acc[i][4 + j] += a[i] * b1[j]; }
            }
        }
    }
#pragma unroll
    for (int i = 0; i < 4; ++i) { const int m = m0 + ty * 4 + i; if (m < Mlim) {
#pragma unroll
        for (int j = 0; j < 8; ++j) { const int n = n0 + tx * 8 + j; if (n < N) ef(m, n, acc[i][j]); } } }
    __syncthreads();
}

namespace pg {
typedef short bf16x8 __attribute__((ext_vector_type(8)));
typedef unsigned u32x4 __attribute__((ext_vector_type(4)));
constexpr int BM = 256, BK = 64, HALF = 128, HTB = HALF * BK * 2, STAGE_BYTES = 8 * HTB;
__device__ __forceinline__ int lds_byte(int r, int c) { const int st = (r >> 4) * 2 + (c >> 5), rr = r & 15, cc = c & 31, ob = rr * 64 + cc * 2; return st * 1024 + (ob ^ (((ob >> 9) & 1) << 5)); }
__device__ __forceinline__ void stage_rc(int b, int& R, int& C) { const int st = b / 1024, sb = b % 1024, swz = sb ^ (((sb >> 9) & 1) << 5); R = (st >> 1) * 16 + swz / 64; C = (st & 1) * 32 + (swz % 64) / 2; }
__device__ __forceinline__ int perm32(int rho) { const int n = rho >> 4, i = rho & 15; return 8 * (i >> 2) + 4 * n + (i & 3); }
__device__ __forceinline__ unsigned cvt_pk_bf16(float lo, float hi) { unsigned r; asm volatile("v_cvt_pk_bf16_f32 %0, %1, %2" : "=v"(r) : "v"(lo), "v"(hi)); return r; }

typedef int i32x4 __attribute__((ext_vector_type(4)));
typedef int i32x8 __attribute__((ext_vector_type(8)));
__device__ __forceinline__ i32x8 cat8(const bf16x8& lo, const bf16x8& hi) { const i32x4 a = __builtin_bit_cast(i32x4, lo), b = __builtin_bit_cast(i32x4, hi); return __builtin_shufflevector(a, b, 0, 1, 2, 3, 4, 5, 6, 7); }
__device__ __forceinline__ void mfma_f8(f32x4& acc, const i32x8& a, const i32x8& b) { asm volatile("v_mfma_f32_16x16x128_f8f6f4 %0, %1, %2, %0" : "+v"(acc) : "v"(a), "v"(b)); }
constexpr int TE_OFF = 131072, ROWS_OFF = 141312, DW_OFF = 143360;
struct Unit { const char* A; const char* B; const int* rows; int pm, pn, aux; };

__device__ __forceinline__ int xcd_remap(int L, int n) { const int q = n / 8, r = n % 8, x = L % 8, off = L / 8; return (x < r ? x * (q + 1) : r * (q + 1) + (x - r) * q) + off; }

template <class Epi, class Sched, bool GATHER, bool FP8 = false>
__device__ __forceinline__ void gemm_phase(LAS unsigned char* lds, const int KB  , const Sched& S, const Epi& E) {
    const int tid = opaque((int)threadIdx.x), wid = __builtin_amdgcn_readfirstlane(tid >> 6), lane = tid & 63, wr = wid >> 2, wc = wid & 3, fr = lane & 15, fq = lane >> 4;
    const int nt = KB / (BK * 2);
    unsigned voffA[2], voffB[2]; int RA[2], CA[2];
#pragma unroll
    for (int i = 0; i < 2; ++i) { int R, C; stage_rc(tid * 16 + i * 8192, R, C); const int Rb = Epi::PERM ? ((R & ~31) + perm32(R & 31)) : R;
        RA[i] = R; CA[i] = C; voffA[i] = (unsigned)(R * KB + C * 2); voffB[i] = (unsigned)(Rb * KB + C * 2); }
    const size_t kstep = (size_t)(BK * 2);
    const size_t hstep = (size_t)HALF * KB;
    const unsigned ldsw = (unsigned)wid * 1024u;
    const int aoff = lds_byte(wr * 64 + fr, FP8 ? fq * 16 : fq * 8), boff = lds_byte(wc * 32 + fr, FP8 ? fq * 16 : fq * 8);

    unsigned vAc[2][2], vAn[2][2];
#define PG_SA(b, h) (((b) * 2 + (h)) * HTB)
#define PG_SB(b, h) ((4 + (b) * 2 + (h)) * HTB)
#define PG_GLDS(gp, off) __builtin_amdgcn_global_load_lds((const unsigned*)(gp), (LAS unsigned*)(lds + (off)), 16, 0, 0)
#define PG_GLDS4(gp, off) __builtin_amdgcn_global_load_lds((const unsigned*)(gp), (LAS unsigned*)(lds + (off)), 4, 0, 0)
#define PG_STAGE_B(bufoff, gbase) do { _Pragma("unroll") for (int _i = 0; _i < 2; ++_i) PG_GLDS((const char*)(gbase) + voffB[_i], (bufoff) + ldsw + _i * 8192); } while (0)
#define PG_STAGE_A(bufoff, gbase, h, NX) do { _Pragma("unroll") for (int _i = 0; _i < 2; ++_i) { \
        const unsigned _v = GATHER ? ((NX) ? vAn[h][_i] : vAc[h][_i]) : voffA[_i]; \
        PG_GLDS((const char*)(gbase) + (GATHER ? (size_t)0 : (size_t)(h) * hstep) + _v, (bufoff) + ldsw + _i * 8192); } } while (0)
#define PG_ROWS(u, vA) do { _Pragma("unroll") for (int _h = 0; _h < 2; ++_h) _Pragma("unroll") for (int _i = 0; _i < 2; ++_i) \
        vA[_h][_i] = (unsigned)((u).rows[_h * HALF + RA[_i]] * KB + CA[_i] * 2); } while (0)
#define PG_LD8(p) __builtin_shufflevector(((const LAS i32x4*)(p))[0], ((const LAS i32x4*)(p))[1], 0, 1, 2, 3, 4, 5, 6, 7)
#define PG_LDA(dst, b, h) do { if constexpr (FP8) { _Pragma("unroll") for (int m = 0; m < 4; ++m) dst##8[m] = PG_LD8(lds + PG_SA(b, h) + aoff + m * 2048); } \
        else { _Pragma("unroll") for (int m = 0; m < 4; ++m) _Pragma("unroll") for (int k = 0; k < 2; ++k) dst[m][k] = *(const LAS bf16x8*)(lds + PG_SA(b, h) + aoff + m * 2048 + k * 1024); } } while (0)
#define PG_LDB(dst, b, h) do { if constexpr (FP8) { _Pragma("unroll") for (int n = 0; n < 2; ++n) dst##8[n] = PG_LD8(lds + PG_SB(b, h) + boff + n * 2048); } \
        else { _Pragma("unroll") for (int n = 0; n < 2; ++n) _Pragma("unroll") for (int k = 0; k < 2; ++k) dst[n][k] = *(const LAS bf16x8*)(lds + PG_SB(b, h) + boff + n * 2048 + k * 1024); } } while (0)
#define PG_MMA(ai, bj, At, Bt) do { __builtin_amdgcn_s_setprio(1); _Pragma("unroll") for (int m = 0; m < 4; ++m) _Pragma("unroll") for (int n = 0; n < 2; ++n) { \
        if constexpr (FP8) mfma_f8(acc[ai][bj][m][n], Bt##8[n], At##8[m]); \
        else { _Pragma("unroll") for (int k = 0; k < 2; ++k) acc[ai][bj][m][n] = __builtin_amdgcn_mfma_f32_16x16x32_bf16(Bt[n][k], At[m][k], acc[ai][bj][m][n], 0, 0, 0); } } \
        __builtin_amdgcn_s_setprio(0); } while (0)
#define PG_WAIT_V(n) asm volatile("s_waitcnt vmcnt(" #n ")" ::: "memory")
#define PG_WAIT_L(n) asm volatile("s_waitcnt lgkmcnt(" #n ")" ::: "memory")
#define PG_BAR __builtin_amdgcn_s_barrier()
#define PG_SCHED __builtin_amdgcn_sched_barrier(0)
    Unit cur, nxt, nn; int ui = 0;
    if (!S.next(0, cur)) return;
    bool has_next = S.next(1, nxt);
    f32x4 acc[2][2][4][2];
#pragma unroll
    for (int a = 0; a < 2; ++a)
#pragma unroll
        for (int b = 0; b < 2; ++b)
#pragma unroll
            for (int m = 0; m < 4; ++m)
#pragma unroll
                for (int n = 0; n < 2; ++n) acc[a][b][m][n] = (f32x4){0.f, 0.f, 0.f, 0.f};
    if constexpr (FP8) {
#pragma unroll
    for (int a = 0; a < 2; ++a)
#pragma unroll
        for (int b = 0; b < 2; ++b) asm volatile("" : "+v"(acc[a][b][0][0]), "+v"(acc[a][b][0][1]), "+v"(acc[a][b][1][0]), "+v"(acc[a][b][1][1]), "+v"(acc[a][b][2][0]), "+v"(acc[a][b][2][1]), "+v"(acc[a][b][3][0]), "+v"(acc[a][b][3][1]));
    }
    bf16x8 At[4][2], B0[2][2], B1[2][2]; i32x8 At8[4], B08[2], B18[2];
    const char* cA = cur.A; const char* cB = cur.B;
    if (GATHER) { PG_ROWS(cur, vAc);
        if (has_next && wid < 4) PG_GLDS4(nxt.rows + tid, ROWS_OFF + 1024 + wid * 256); }
    PG_STAGE_B(PG_SB(0, 0), cB); PG_STAGE_A(PG_SA(0, 0), cA, 0, false); PG_STAGE_B(PG_SB(0, 1), cB + hstep); PG_STAGE_A(PG_SA(0, 1), cA, 1, false);
    if (wr == 1) PG_BAR;
    PG_WAIT_V(4); PG_BAR;
    PG_STAGE_B(PG_SB(1, 0), cB + kstep); PG_STAGE_A(PG_SA(1, 0), cA + kstep, 0, false); PG_STAGE_B(PG_SB(1, 1), cB + hstep + kstep);
    PG_WAIT_V(6); PG_BAR;
    for (;;) {
        const bool has_nn = has_next ? S.next(ui + 2, nn) : false;
        const char* nA = has_next ? nxt.A : cA; const char* nB = has_next ? nxt.B : cB;
        if (GATHER) { if (has_nn && wid < 4) PG_GLDS4(nn.rows + tid, ROWS_OFF + (ui & 1) * 1024 + wid * 256);
            if (has_next) { const LAS int* rs = (const LAS int*)(lds + ROWS_OFF + ((ui + 1) & 1) * 1024);
#pragma unroll
            for (int h = 0; h < 2; ++h)
#pragma unroll
                for (int i = 0; i < 2; ++i) vAn[h][i] = (unsigned)(rs[h * HALF + RA[i]] * KB + CA[i] * 2); } else {
#pragma unroll
            for (int h = 0; h < 2; ++h)
#pragma unroll
                for (int i = 0; i < 2; ++i) vAn[h][i] = vAc[h][i]; } }
        if constexpr (Epi::PRE) E.pre(lds, cur, ui, tid, wid);
#pragma unroll 1
        for (int t = 0; t < nt; t += 2) {
            const bool last = (t == nt - 2);
            const char* a1 = cA + (size_t)(t + 1) * kstep;
            const char* a2 = last ? nA : cA + (size_t)(t + 2) * kstep; const char* b2 = last ? nB : cB + (size_t)(t + 2) * kstep;
            const char* a3 = a2 + kstep; const char* b3 = b2 + kstep;
            PG_LDB(B0, 0, 0); PG_SCHED; PG_LDA(At, 0, 0); PG_STAGE_A(PG_SA(1, 1), a1, 1, false);
            PG_WAIT_L(8); PG_BAR; PG_WAIT_L(0); PG_MMA(0, 0, At, B0); PG_BAR; PG_SCHED;
            PG_LDB(B1, 0, 1); PG_STAGE_B(PG_SB(0, 0), b2);
            PG_BAR; PG_WAIT_L(0); PG_MMA(0, 1, At, B1); PG_BAR;
            PG_LDA(At, 0, 1); PG_STAGE_A(PG_SA(0, 0), a2, 0, last);
            PG_BAR; PG_WAIT_L(0); PG_MMA(1, 0, At, B0); PG_BAR; PG_SCHED;
            PG_STAGE_B(PG_SB(0, 1), b2 + hstep);
            PG_WAIT_V(6); PG_BAR; PG_MMA(1, 1, At, B1); PG_BAR;
            PG_LDB(B0, 1, 0); PG_SCHED; PG_LDA(At, 1, 0); PG_STAGE_A(PG_SA(0, 1), a2, 1, last);
            PG_WAIT_L(8); PG_BAR; PG_WAIT_L(0); PG_MMA(0, 0, At, B0); PG_BAR; PG_SCHED;
            PG_LDB(B1, 1, 1); PG_STAGE_B(PG_SB(1, 0), b3);
            PG_BAR; PG_WAIT_L(0); PG_MMA(0, 1, At, B1); PG_BAR;
            PG_LDA(At, 1, 1); PG_STAGE_A(PG_SA(1, 0), a3, 0, last);
            PG_BAR; PG_WAIT_L(0); PG_MMA(1, 0, At, B0); PG_BAR; PG_SCHED;
            PG_STAGE_B(PG_SB(1, 1), b3 + hstep);
            PG_WAIT_V(6); PG_BAR; PG_MMA(1, 1, At, B1); PG_BAR;
        }
        if constexpr (FP8) asm volatile("s_nop 15\n\ts_nop 15" ::: "memory");
        if constexpr (Epi::PRE) E.run(acc, cur, wr, wc, fr, fq, lds, ui); else E(acc, cur, wr, wc, fr, fq);
        if (!has_next) break;
#pragma unroll
        for (int a = 0; a < 2; ++a)
#pragma unroll
            for (int b = 0; b < 2; ++b)
#pragma unroll
                for (int m = 0; m < 4; ++m)
#pragma unroll
                    for (int n = 0; n < 2; ++n) acc[a][b][m][n] = (f32x4){0.f, 0.f, 0.f, 0.f};
        if constexpr (FP8) {
#pragma unroll
        for (int a = 0; a < 2; ++a)
#pragma unroll
            for (int b = 0; b < 2; ++b) asm volatile("" : "+v"(acc[a][b][0][0]), "+v"(acc[a][b][0][1]), "+v"(acc[a][b][1][0]), "+v"(acc[a][b][1][1]), "+v"(acc[a][b][2][0]), "+v"(acc[a][b][2][1]), "+v"(acc[a][b][3][0]), "+v"(acc[a][b][3][1]));
        }
        cur = nxt; cA = nA; cB = nB; ++ui; nxt = nn; has_next = has_nn;
        if (GATHER) {
#pragma unroll
            for (int h = 0; h < 2; ++h)
#pragma unroll
                for (int i = 0; i < 2; ++i) vAc[h][i] = vAn[h][i]; }
    }
    PG_WAIT_V(0);
    if (wr == 0) PG_BAR;
    PG_BAR;
#undef PG_SA
#undef PG_SB
#undef PG_GLDS
#undef PG_GLDS4
#undef PG_STAGE_A
#undef PG_STAGE_B
#undef PG_ROWS
#undef PG_LD8
#undef PG_LDA
#undef PG_LDB
#undef PG_MMA
#undef PG_WAIT_V
#undef PG_WAIT_L
#undef PG_BAR
#undef PG_SCHED
}

struct DenseOrder {
    const char* A; const char* Bt; int KB, nM, nN, nwg, G, c; int own = 0;
    __device__ __forceinline__ bool next(int i, Unit& u) const {
        if (own) { if (i >= nN) return false; u.pm = c; u.pn = i; u.rows = nullptr; u.aux = 0; u.A = A + (size_t)u.pm * 256 * KB; u.B = Bt + (size_t)u.pn * 256 * KB; return true; }
        const long L = (long)i * G + c; if (L >= nwg) return false;
        const int wgid = xcd_remap((int)L, nwg);
        const int nig = 8 * nN, gid = wgid / nig, fm = gid * 8, gsz = (nM - fm) < 8 ? (nM - fm) : 8;
        u.pm = fm + ((wgid % nig) % gsz); u.pn = (wgid % nig) / gsz; u.rows = nullptr; u.aux = 0;
        u.A = A + (size_t)u.pm * 256 * KB; u.B = Bt + (size_t)u.pn * 256 * KB; return true;
    }
};

struct EpiP2 {
    static constexpr bool PERM = true, DBL = false, PRE = false;
    bf16 *PQK, *PV, *PO, *RAW, *PZ; float* GATES;
    __device__ __forceinline__ void operator()(const f32x4 (&acc)[2][2][4][2], const Unit& u, int wr, int wc, int fr, int fq) const {
        const int row0 = u.pm * BM + wr * 64 + fr, pn = u.pn;
        if (pn == 14) {
            if (wc == 0) {
#pragma unroll
                for (int ai = 0; ai < 2; ++ai)
#pragma unroll
                    for (int m = 0; m < 4; ++m) { float* g = GATES + (size_t)(row0 + ai * HALF + m * 16) * 32 + 8 * fq; *(f32x4*)g = acc[ai][0][m][0]; *(f32x4*)(g + 4) = acc[ai][0][m][1]; }
            }
            return;
        }
        bf16* base; int ldc = 512;
        if (pn < 2) base = PQK + pn * 256; else if (pn < 4) base = PV + (pn - 2) * 256; else if (pn < 6) base = PO + (pn - 4) * 256;
        else if (pn < 12) { base = RAW + (pn - 6) * 256; ldc = 1536; } else base = PZ + (pn - 12) * 256;
        const int col0 = wc * 32 + 8 * fq;
#pragma unroll
        for (int ai = 0; ai < 2; ++ai)
#pragma unroll
            for (int m = 0; m < 4; ++m) { bf16* rowp = base + (size_t)(row0 + ai * HALF + m * 16) * ldc + col0;
#pragma unroll
                for (int bj = 0; bj < 2; ++bj) { const f32x4 v0 = acc[ai][bj][m][0], v1 = acc[ai][bj][m][1];
                    u32x4 w; w.x = cvt_pk_bf16(v0[0], v0[1]); w.y = cvt_pk_bf16(v0[2], v0[3]); w.z = cvt_pk_bf16(v1[0], v1[1]); w.w = cvt_pk_bf16(v1[2], v1[3]);
                    *(u32x4*)(rowp + bj * HALF) = w; } }
    }
};
struct EpiBf16 {
    static constexpr bool PERM = true, DBL = false, PRE = false;
    bf16* O; int ldc;
    __device__ __forceinline__ void operator()(const f32x4 (&acc)[2][2][4][2], const Unit& u, int wr, int wc, int fr, int fq) const {
        const int row0 = u.pm * BM + wr * 64 + fr, col0 = u.pn * BM + wc * 32 + 8 * fq;
#pragma unroll
        for (int ai = 0; ai < 2; ++ai)
#pragma unroll
            for (int m = 0; m < 4; ++m) { bf16* rowp = O + (size_t)(row0 + ai * HALF + m * 16) * ldc + col0;
#pragma unroll
                for (int bj = 0; bj < 2; ++bj) { const f32x4 v0 = acc[ai][bj][m][0], v1 = acc[ai][bj][m][1];
                    u32x4 w; w.x = cvt_pk_bf16(v0[0], v0[1]); w.y = cvt_pk_bf16(v0[2], v0[3]); w.z = cvt_pk_bf16(v1[0], v1[1]); w.w = cvt_pk_bf16(v1[2], v1[3]);
                    *(u32x4*)(rowp + bj * HALF) = w; } }
    }
};
struct EpiGU {
    static constexpr bool PERM = true, DBL = false, PRE = false;
    bf16* O;
    __device__ __forceinline__ void operator()(const f32x4 (&acc)[2][2][4][2], const Unit& u, int wr, int wc, int fr, int fq) const {
        const int row0 = u.pm * BM + wr * 64 + fr, col0 = u.pn * HALF + wc * 32 + 8 * fq;
#pragma unroll
        for (int ai = 0; ai < 2; ++ai)
#pragma unroll
            for (int m = 0; m < 4; ++m) { float h[8];
#pragma unroll
                for (int n = 0; n < 2; ++n)
#pragma unroll
                    for (int j = 0; j < 4; ++j) { const float g = acc[ai][0][m][n][j], up = acc[ai][1][m][n][j]; h[n * 4 + j] = g * __builtin_amdgcn_rcpf(1.0f + __expf(-g)) * up; }
                u32x4 w; w.x = cvt_pk_bf16(h[0], h[1]); w.y = cvt_pk_bf16(h[2], h[3]); w.z = cvt_pk_bf16(h[4], h[5]); w.w = cvt_pk_bf16(h[6], h[7]);
                *(u32x4*)(O + (size_t)(row0 + ai * HALF + m * 16) * 256 + col0) = w; }
    }
};
struct EpiGU8 {
    static constexpr bool PERM = true, DBL = false, PRE = false;
    unsigned char* O;
    __device__ __forceinline__ void operator()(const f32x4 (&acc)[2][2][4][2], const Unit& u, int wr, int wc, int fr, int fq) const {
        const int row0 = u.pm * BM + wr * 64 + fr, col0 = u.pn * HALF + wc * 32 + 8 * fq;
#pragma unroll
        for (int ai = 0; ai < 2; ++ai)
#pragma unroll
            for (int m = 0; m < 4; ++m) { float h[8];
#pragma unroll
                for (int n = 0; n < 2; ++n)
#pragma unroll
                    for (int j = 0; j < 4; ++j) { const float g = acc[ai][0][m][n][j] * (1.f / 64.f), up = acc[ai][1][m][n][j] * (8.f / 64.f);
                        h[n * 4 + j] = fminf(fmaxf(g * __builtin_amdgcn_rcpf(1.0f + __expf(-g)) * up, -448.f), 448.f); }
                int lo = 0, hi = 0;
                lo = __builtin_amdgcn_cvt_pk_fp8_f32(h[0], h[1], lo, false); lo = __builtin_amdgcn_cvt_pk_fp8_f32(h[2], h[3], lo, true);
                hi = __builtin_amdgcn_cvt_pk_fp8_f32(h[4], h[5], hi, false); hi = __builtin_amdgcn_cvt_pk_fp8_f32(h[6], h[7], hi, true);
                typedef unsigned u32x2 __attribute__((ext_vector_type(2))); u32x2 o; o.x = (unsigned)lo; o.y = (unsigned)hi;
                *(u32x2*)(O + (size_t)(row0 + ai * HALF + m * 16) * 256 + col0) = o; }
    }
};
struct EpiF32 {
    static constexpr bool PERM = false, DBL = false, PRE = false;
    float* C0; float* C1; int ldc;
    __device__ __forceinline__ void operator()(const f32x4 (&acc)[2][2][4][2], const Unit& u, int wr, int wc, int fr, int fq) const {
        float* C = u.pn ? C1 : C0;
        const int row0 = u.pm * BM + wr * 64 + fr, col0 = wc * 32 + 4 * fq;
#pragma unroll
        for (int ai = 0; ai < 2; ++ai)
#pragma unroll
            for (int m = 0; m < 4; ++m) { float* rowp = C + (size_t)(row0 + ai * HALF + m * 16) * ldc + col0;
#pragma unroll
                for (int bj = 0; bj < 2; ++bj)
#pragma unroll
                    for (int n = 0; n < 2; ++n) *(f32x4*)(rowp + bj * HALF + n * 16) = acc[ai][bj][m][n]; }
    }
};
template <bool SHARED, bool NOST = false> struct EpiContrib {
    static constexpr bool PERM = true, DBL = true, PRE = !SHARED;
    unsigned char* C; const int* LDST; const float* LW;
    __device__ __forceinline__ void pre(LAS unsigned char* lds, const Unit& u, int ui, int tid, int wid) const {
        const int p = u.pm * BM + (tid & 255);
        const void* g = wid < 4 ? (const void*)(LDST + p) : (const void*)(LW + p);
        __builtin_amdgcn_global_load_lds((const unsigned*)g, (LAS unsigned*)(lds + DW_OFF + (ui & 1) * 2048 + wid * 256), 4, 0, 0);
    }
    __device__ __forceinline__ void operator()(const f32x4 (&acc)[2][2][4][2], const Unit& u, int wr, int wc, int fr, int fq) const { run(acc, u, wr, wc, fr, fq, nullptr, 0); }
    __device__ __forceinline__ void run(const f32x4 (&acc)[2][2][4][2], const Unit& u, int wr, int wc, int fr, int fq, LAS unsigned char* lds, int ui) const {
        const int row0 = u.pm * BM + wr * 64 + fr, col0 = u.pn * BM + wc * 32 + 8 * fq;
        int dstv[8]; float wv[8];
        const LAS int* sd = (const LAS int*)(lds + DW_OFF + (ui & 1) * 2048); const LAS float* sw = (const LAS float*)(sd + 256);
#pragma unroll
        for (int i = 0; i < 8; ++i) { const int p = row0 + (i >> 2) * HALF + (i & 3) * 16, pl = wr * 64 + fr + (i >> 2) * HALF + (i & 3) * 16;
            if constexpr (SHARED) { dstv[i] = p * 9 + 8; wv[i] = 16.f / 256.f; } else { dstv[i] = sd[pl]; wv[i] = sw[pl] * (16.f / 256.f); } }
#pragma unroll
        for (int ai = 0; ai < 2; ++ai)
#pragma unroll
            for (int m = 0; m < 4; ++m) { const int dst = dstv[ai * 4 + m]; const float w = wv[ai * 4 + m];
                if (dst >= 0) { unsigned char* rowp = C + (size_t)dst * 1024 + col0;
#pragma unroll
                    for (int bj = 0; bj < 2; ++bj) { f32x4 v0 = acc[ai][bj][m][0] * w, v1 = acc[ai][bj][m][1] * w;
#pragma unroll
                        for (int j = 0; j < 4; ++j) { v0[j] = fminf(fmaxf(v0[j], -448.f), 448.f); v1[j] = fminf(fmaxf(v1[j], -448.f), 448.f); }
                        int lo = 0, hi = 0;
                        lo = __builtin_amdgcn_cvt_pk_fp8_f32(v0[0], v0[1], lo, false); lo = __builtin_amdgcn_cvt_pk_fp8_f32(v0[2], v0[3], lo, true);
                        hi = __builtin_amdgcn_cvt_pk_fp8_f32(v1[0], v1[1], hi, false); hi = __builtin_amdgcn_cvt_pk_fp8_f32(v1[2], v1[3], hi, true);
                        typedef unsigned u32x2 __attribute__((ext_vector_type(2))); u32x2 o; o.x = (unsigned)lo; o.y = (unsigned)hi;
                        if constexpr (NOST) asm volatile("" :: "v"(o), "v"(rowp)); else *(u32x2*)(rowp + bj * HALF) = o; } } }
    }
};

struct RoutedGuOrder {
    const char* HFFN; const char* WguT; const int* LTOK; const LAS int* TE; int KB, ntot, G, c;
    __device__ __forceinline__ bool next(int i, Unit& u) const {
        const long L = (long)i * G + c; if (L >= ntot) return false;
        const int nat = xcd_remap((int)L, ntot), r = nat >> 1, pn = nat & 1, e = TE[r];
        u.pm = r; u.pn = pn; u.aux = e; u.rows = LTOK + (size_t)r * 256; u.A = HFFN; u.B = WguT + ((size_t)e * 512 + pn * 256) * KB; return true;
    }
};
struct RoutedDownOrder {
    const char* HB; const char* WdT; const LAS int* TE; int KB, r0, ntot, G, c;
    __device__ __forceinline__ bool next(int i, Unit& u) const {
        const long L = (long)i * G + c; if (L >= ntot) return false;
        const int nat = xcd_remap((int)L, ntot), r = r0 + (nat >> 2), pn = nat & 3, e = TE[r];
        u.pm = r; u.pn = pn; u.aux = e; u.rows = nullptr; u.A = HB + (size_t)r * 256 * KB; u.B = WdT + ((size_t)e * 1024 + pn * 256) * KB; return true;
    }
};
}

template <bool LO = false, class RM>
__device__ __forceinline__ void transpose_item(const float* W, int K, int N, bf16* WT, LAS float* scr, int item, int lane, const RM& rm) {
    const int nblk = N / 32, kb = item / nblk, nb = item % nblk, k0 = 64 * kb, n0 = 32 * nb;
#pragma unroll 8
    for (int i = 0; i < 32; ++i) { const int kk = 2 * i + (lane >> 5); float wv = W[(size_t)(k0 + kk) * N + n0 + (lane & 31)]; if (LO) wv -= bf2f(f2bf(wv)); scr[kk * 33 + (lane & 31)] = wv; }
    asm volatile("s_waitcnt lgkmcnt(0)" ::: "memory");
    const int c = lane & 7;
#pragma unroll
    for (int j = 0; j < 4; ++j) { const int n = (lane >> 3) + 8 * j; const LAS float* s = scr + (8 * c) * 33 + n; int row; float sc; rm(n0 + n, row, sc);
        uint4 o; o.x = (unsigned)f2bf(s[0 * 33] * sc) | ((unsigned)f2bf(s[1 * 33] * sc) << 16); o.y = (unsigned)f2bf(s[2 * 33] * sc) | ((unsigned)f2bf(s[3 * 33] * sc) << 16);
        o.z = (unsigned)f2bf(s[4 * 33] * sc) | ((unsigned)f2bf(s[5 * 33] * sc) << 16); o.w = (unsigned)f2bf(s[6 * 33] * sc) | ((unsigned)f2bf(s[7 * 33] * sc) << 16);
        *(uint4*)(WT + (size_t)row * K + k0 + 8 * c) = o; }
    asm volatile("s_waitcnt lgkmcnt(0)" ::: "memory");
}

template <class RM>
__device__ __forceinline__ void transpose_item_f8(const float* W, int K, int N, unsigned char* WT, LAS float* scr, int item, int lane, const RM& rm) {
    const int nblk = N / 32, kb = item / nblk, nb = item % nblk, k0 = 64 * kb, n0 = 32 * nb;
#pragma unroll 8
    for (int i = 0; i < 32; ++i) { const int kk = 2 * i + (lane >> 5); scr[kk * 33 + (lane & 31)] = W[(size_t)(k0 + kk) * N + n0 + (lane & 31)]; }
    asm volatile("s_waitcnt lgkmcnt(0)" ::: "memory");
    const int c = lane & 7;
#pragma unroll
    for (int j = 0; j < 4; ++j) { const int n = (lane >> 3) + 8 * j; const LAS float* s = scr + (8 * c) * 33 + n; int row; float sc; rm(n0 + n, row, sc);
        int lo = 0, hi = 0;
        lo = __builtin_amdgcn_cvt_pk_fp8_f32(s[0 * 33] * sc, s[1 * 33] * sc, lo, false); lo = __builtin_amdgcn_cvt_pk_fp8_f32(s[2 * 33] * sc, s[3 * 33] * sc, lo, true);
        hi = __builtin_amdgcn_cvt_pk_fp8_f32(s[4 * 33] * sc, s[5 * 33] * sc, hi, false); hi = __builtin_amdgcn_cvt_pk_fp8_f32(s[6 * 33] * sc, s[7 * 33] * sc, hi, true);
        typedef unsigned u32x2 __attribute__((ext_vector_type(2))); u32x2 o; o.x = (unsigned)lo; o.y = (unsigned)hi;
        *(u32x2*)(WT + (size_t)row * K + k0 + 8 * c) = o; }
    asm volatile("s_waitcnt lgkmcnt(0)" ::: "memory");
}

typedef float cf32x4 __attribute__((ext_vector_type(4)));
typedef unsigned cu32x4 __attribute__((ext_vector_type(4)));
struct ConvRegs { cf32x4 v[16]; };
__device__ __forceinline__ void conv_load(ConvRegs& R, const float* W, int N, int k0, int n0, int lane) {
    const float* src = W + (size_t)(k0 + (lane >> 3)) * N + n0 + (lane & 7) * 4;
#pragma unroll
    for (int i = 0; i < 16; ++i) R.v[i] = *(const cf32x4*)(src + (size_t)(8 * i) * N);
}
template <class RM>
__device__ __forceinline__ void conv_store(const ConvRegs& R, int K, unsigned char* WT, LAS float* scr, int k0, int n0, int lane, const RM& rm) {
#pragma unroll
    for (int i = 0; i < 16; ++i) { LAS float* d = scr + (8 * i + (lane >> 3)) * 33 + (lane & 7) * 4; d[0] = R.v[i][0]; d[1] = R.v[i][1]; d[2] = R.v[i][2]; d[3] = R.v[i][3]; }
    asm volatile("s_waitcnt lgkmcnt(0)" ::: "memory");
    const int kc = lane & 7;
#pragma unroll
    for (int j = 0; j < 4; ++j) { const int n = (lane >> 3) + 8 * j; int row; float sc; rm(n0 + n, row, sc);
        const LAS float* s = scr + (16 * kc) * 33 + n; cu32x4 o;
#pragma unroll
        for (int q = 0; q < 4; ++q) { int p = 0; p = __builtin_amdgcn_cvt_pk_fp8_f32(s[(4 * q) * 33] * sc, s[(4 * q + 1) * 33] * sc, p, false); p = __builtin_amdgcn_cvt_pk_fp8_f32(s[(4 * q + 2) * 33] * sc, s[(4 * q + 3) * 33] * sc, p, true); o[q] = (unsigned)p; }
        *(cu32x4*)(WT + (size_t)row * K + k0 + 16 * kc) = o; }
    asm volatile("s_waitcnt lgkmcnt(0)" ::: "memory");
}
__device__ __forceinline__ void conv_chunk(const float* wg, const float* wu, const float* wd, unsigned char* WGU8, unsigned char* WD8, LAS float* scr, int q, int c, int lane) {
    ConvRegs RA, RB;
    if (q == 0 && c < 2048) { const int e = c >> 3, kb = (c >> 2) & 1, ng = c & 3; const float* W = wd + (size_t)e * DE * D; unsigned char* WT = WD8 + (size_t)e * D * DE;
        auto rm = [](int n, int& row, float& sc) { sc = 32.f; row = n; };
        const int k0 = 128 * kb, nb = 256 * ng;
        conv_load(RA, W, D, k0, nb, lane);
#pragma unroll 1
        for (int s = 0; s < 8; s += 2) { conv_load(RB, W, D, k0, nb + 32 * (s + 1), lane); conv_store(RA, DE, WT, scr, k0, nb + 32 * s, lane, rm);
            if (s + 2 < 8) conv_load(RA, W, D, k0, nb + 32 * (s + 2), lane);
            conv_store(RB, DE, WT, scr, k0, nb + 32 * (s + 1), lane, rm); }
    } else { const int cc = q == 0 ? c - 2048 : c, e = (q == 0 ? 0 : 128) + (cc >> 4), mat = (cc >> 3) & 1, kb = cc & 7;
        const float* W = (mat ? wu : wg) + (size_t)e * D * DE; unsigned char* WT = WGU8 + (size_t)e * 512 * D;
        auto rm = [mat](int n, int& row, float& sc) { sc = 64.f; row = 256 * (n >> 7) + 128 * mat + (n & 127); };
        const int k0 = 128 * kb;
        conv_load(RA, W, DE, k0, 0, lane);
#pragma unroll 1
        for (int s = 0; s < 8; s += 2) { conv_load(RB, W, DE, k0, 32 * (s + 1), lane); conv_store(RA, D, WT, scr, k0, 32 * s, lane, rm);
            if (s + 2 < 8) conv_load(RA, W, DE, k0, 32 * (s + 2), lane);
            conv_store(RB, D, WT, scr, k0, 32 * (s + 1), lane, rm); }
    }
}

typedef short bf16x8 __attribute__((ext_vector_type(8)));
typedef unsigned u4v __attribute__((ext_vector_type(4)));
typedef unsigned u2v __attribute__((ext_vector_type(2)));
__device__ __forceinline__ u4v mk4(unsigned a, unsigned b, unsigned c, unsigned d) { u4v r; r.x = a; r.y = b; r.z = c; r.w = d; return r; }
__device__ __forceinline__ u2v mk2(unsigned a, unsigned b) { u2v r; r.x = a; r.y = b; return r; }
#define MFMA16(a, b, c) __builtin_amdgcn_mfma_f32_16x16x32_bf16(a, b, c, 0, 0, 0)
__device__ __forceinline__ bf16x8 ldfrag(const LAS bf16* base, int pitch, int r0, int k0, int lane) { return *(const LAS bf16x8*)(base + (r0 + (lane & 15)) * pitch + k0 + 8 * (lane >> 4)); }
__device__ __forceinline__ void lds8(const LAS float* p, float (&f)[8]) { const f32x4 a = *(const LAS f32x4*)p, b = *(const LAS f32x4*)(p + 4); f[0] = a[0]; f[1] = a[1]; f[2] = a[2]; f[3] = a[3]; f[4] = b[0]; f[5] = b[1]; f[6] = b[2]; f[7] = b[3]; }
__device__ __forceinline__ unsigned pk2(float lo, float hi) { return (unsigned)f2bf(lo) | ((unsigned)f2bf(hi) << 16); }
__device__ __forceinline__ void unpack8(const u4v& u, float (&f)[8]) {
    f[0] = bf2f((bf16)(u.x & 0xffffu)); f[1] = bf2f((bf16)(u.x >> 16)); f[2] = bf2f((bf16)(u.y & 0xffffu)); f[3] = bf2f((bf16)(u.y >> 16));
    f[4] = bf2f((bf16)(u.z & 0xffffu)); f[5] = bf2f((bf16)(u.z >> 16)); f[6] = bf2f((bf16)(u.w & 0xffffu)); f[7] = bf2f((bf16)(u.w >> 16)); }
__device__ __forceinline__ u4v pack8(const float (&f)[8]) { return mk4(pk2(f[0], f[1]), pk2(f[2], f[3]), pk2(f[4], f[5]), pk2(f[6], f[7])); }
constexpr int NCH = 132;
constexpr int MSCN = 336, GSCN = 272;
struct ScanBufs {
    const bf16 *PQK, *PV, *RAW; const float* GATES;
    bf16 *MQ, *MKT, *MQK, *MVT; float* MSC;
    bf16 *GQ, *GKT, *GVT, *GQK, *GT; float* GSC;
    bf16 *HML, *OGD;
    const float *ib, *fb, *cw, *alog, *dtb;
};
__device__ __forceinline__ int chunk_row(int b, int c, int t, bool gdn) {
    if (c < 4) return T + b * CTXL + 64 * c + t;
    const int cl = c - 4;
    return gdn ? b * SEQ + ((cl & 1) * 64 + t) * GW_ + (cl >> 1) : b * SEQ + 64 * cl + t;
}

#define LDS_BARRIER() do { asm volatile("s_waitcnt lgkmcnt(0)" ::: "memory"); __builtin_amdgcn_s_barrier(); asm volatile("" ::: "memory"); } while (0)
struct PrepMRegs { u4v q, k, v[2]; float fp, ip; };
__device__ __forceinline__ void prep_mlstm_load(const ScanBufs& sb, PrepMRegs& R, int b, int h, int c) {
    const int tid = opaque((int)threadIdx.x), lane = tid & 63, wave = __builtin_amdgcn_readfirstlane(tid >> 6);
    const int row0 = chunk_row(b, c, 0, false); const int t = tid >> 3, p = tid & 7;
    R.q = *(const u4v*)(sb.PQK + (size_t)(row0 + t) * 512 + h * 64 + p * 8); R.k = *(const u4v*)(sb.PQK + (size_t)(row0 + t) * 512 + 256 + h * 64 + p * 8);
#pragma unroll
    for (int i = 0; i < 2; ++i) { const int idx = tid + i * NTHR, tv = idx >> 4, pv = idx & 15; R.v[i] = *(const u4v*)(sb.PV + (size_t)(row0 + tv) * 512 + h * 128 + pv * 8); }
    R.fp = 0.f; R.ip = 0.f;
    if (wave == 0 || wave == 4) { const int dir = wave >> 2, tt = dir ? 63 - lane : lane;
        R.fp = sb.GATES[(size_t)(row0 + tt) * 32 + dir * 8 + 4 + h]; R.ip = sb.GATES[(size_t)(row0 + tt) * 32 + dir * 8 + h]; }
}
template <class NextLoad>
__device__ __forceinline__ void prep_mlstm_item(const ScanBufs& sb, LAS unsigned char* lds, int b, int h, int c, PrepMRegs& R, const NextLoad& next_load) {
    const int tid = opaque((int)threadIdx.x), lane = tid & 63, wave = __builtin_amdgcn_readfirstlane(tid >> 6);
    LAS bf16* Qs = (LAS bf16*)lds; LAS bf16* Ks = Qs + 64 * 72; LAS bf16* Vs = Ks + 64 * 72;
    LAS float* QKf = (LAS float*)(Vs + 64 * 136); LAS float* SC = QKf + 64 * 65;
    const int item = (b * 4 + h) * NCH + c;
    const int row0 = chunk_row(b, c, 0, false);
    const float gfp = R.fp, gip = R.ip;
    { const int t = tid >> 3, p = tid & 7;
      const u4v qv = R.q, kv = R.k;
      *(LAS u4v*)(Qs + t * 72 + p * 8) = qv; *(LAS u4v*)(Ks + t * 72 + p * 8) = kv;
      *(u4v*)(sb.MQ + (size_t)item * 4096 + t * 64 + p * 8) = qv;
#pragma unroll
      for (int i = 0; i < 2; ++i) { const int idx = tid + i * NTHR, tv = idx >> 4, pv = idx & 15;
          *(LAS u4v*)(Vs + tv * 136 + pv * 8) = R.v[i]; } }
    next_load();
    LDS_BARRIER();
    { const int d = tid >> 3, t0 = (tid & 7) * 8; float f[8];
#pragma unroll
      for (int e = 0; e < 8; ++e) f[e] = bf2f(Ks[(t0 + e) * 72 + d]);
      *(u4v*)(sb.MKT + (size_t)item * 4096 + d * 64 + t0) = pack8(f);
#pragma unroll
      for (int i = 0; i < 2; ++i) { const int idx = tid + i * NTHR, dv = idx >> 3, tv0 = (idx & 7) * 8;
#pragma unroll
          for (int e = 0; e < 8; ++e) f[e] = bf2f(Vs[(tv0 + e) * 136 + dv]);
          *(u4v*)(sb.MVT + (size_t)item * 8192 + dv * 64 + tv0) = pack8(f); } }
    { const int rt = wave >> 1;
#pragma unroll
      for (int cc = 0; cc < 2; ++cc) { const int ct = 2 * (wave & 1) + cc; f32x4 acc = {0.f, 0.f, 0.f, 0.f};
#pragma unroll
          for (int ks = 0; ks < 2; ++ks) acc = MFMA16(ldfrag(Qs, 72, 16 * rt, 32 * ks, lane), ldfrag(Ks, 72, 16 * ct, 32 * ks, lane), acc);
#pragma unroll
          for (int j = 0; j < 4; ++j) QKf[(16 * rt + 4 * (lane >> 4) + j) * 65 + 16 * ct + (lane & 15)] = acc[j]; } }
    if (wave == 0 || wave == 4) {
        const int dir = wave >> 2, t = dir ? 63 - lane : lane;
        const LAS float* BT = (const LAS float*)(lds + 163840 - 512);
        const float fp = gfp + BT[8 + dir * 4 + h], ip = gip + BT[dir * 4 + h];
        float a = fp > 0.f ? -log1pf(__expf(-fp)) : fp - log1pf(__expf(fp));
#pragma unroll
        for (int o = 1; o < 64; o <<= 1) { const float v = __shfl_up(a, o); if (lane >= o) a += v; }
        const float bend = __shfl(a, 63), wsv = __expf(bend - a + ip);
        SC[(dir * 3 + 0) * 64 + t] = a; SC[(dir * 3 + 1) * 64 + t] = ip; SC[(dir * 3 + 2) * 64 + t] = wsv;
        float* ms = sb.MSC + ((size_t)((b * 4 + h) * 2 + dir) * NCH + c) * MSCN;
        ms[t] = a; ms[64 + t] = ip; ms[128 + t] = wsv; if (lane == 0) ms[320] = __expf(bend);
    }
    LDS_BARRIER();
    { const int t = tid >> 3, s0 = (tid & 7) * 8; float f[8];
#pragma unroll
      for (int e = 0; e < 8; ++e) f[e] = QKf[t * 65 + s0 + e];
      *(u4v*)(sb.MQK + (size_t)item * 4096 + t * 64 + s0) = pack8(f); }
    { const int dir = tid >> 8, u = tid & 255, r = u >> 2, part = u & 3;
      const LAS float* bb = SC + (dir * 3) * 64; const LAS float* ipp = bb + 64; const LAS float* wss = bb + 128;
      float den = 0.f, ksum = 0.f; const float bt = bb[r];
#pragma unroll
      for (int e = 0; e < 16; ++e) { const int s = part * 16 + e; const bool le = dir ? (s >= r) : (s <= r);
          den += le ? QKf[r * 65 + s] * __expf(bt - bb[s] + ipp[s]) : 0.f; ksum += bf2f(Ks[s * 72 + r]) * wss[s]; }
      den += dpp_f<0xB1>(den); den += dpp_f<0x4E>(den); ksum += dpp_f<0xB1>(ksum); ksum += dpp_f<0x4E>(ksum);
      if (part == 0) { float* ms = sb.MSC + ((size_t)((b * 4 + h) * 2 + dir) * NCH + c) * MSCN; ms[192 + r] = den; ms[256 + r] = ksum; } }
    LDS_BARRIER();
}

struct PrepGRegs { u4v raw[7]; f32x4 cw; float ga, gb; };
__device__ __forceinline__ void prep_gdn_load(const ScanBufs& sb, PrepGRegs& R, int b, int h, int c) {
    const int tid = opaque((int)threadIdx.x), lane = tid & 63, wave = __builtin_amdgcn_readfirstlane(tid >> 6);
#pragma unroll
    for (int i = 0; i < 7; ++i) { const int idx = tid + i * NTHR; R.raw[i] = (u4v){0u, 0u, 0u, 0u};
        if (idx < 68 * 48) { const int rr = idx / 48, pc = idx % 48, sl = pc >> 4, off = (pc & 15) * 8; int row = -1;
            if (c < 4) { const int pos = 64 * c + rr - 2; if (pos >= 0 && pos < CTXL) row = T + b * CTXL + pos; }
            else { const int j = 64 * (c - 4) + rr - 2; if (j >= 0 && j < SEQ) row = b * SEQ + (j % ROWS) * GW_ + j / ROWS; }
            if (row >= 0) R.raw[i] = *(const u4v*)(sb.RAW + (size_t)row * 1536 + sl * 512 + h * 128 + off); } }
    R.cw = (f32x4){0.f, 0.f, 0.f, 0.f};
    if (tid < 480) { const int idx = tid * 4, w = idx / 384, ch = idx % 384; R.cw = *(const f32x4*)(sb.cw + w * 1536 + (ch >> 7) * 512 + h * 128 + (ch & 127)); }
    R.ga = 0.f; R.gb = 0.f;
    if (wave == 0 || wave == 4) { const int dir = wave >> 2, t = dir ? 63 - lane : lane; const int row = chunk_row(b, c, t, true);
        R.ga = sb.GATES[(size_t)row * 32 + 16 + dir * 8 + h]; R.gb = sb.GATES[(size_t)row * 32 + 16 + dir * 8 + 4 + h]; }
}
template <class NextLoad>
__device__ __forceinline__ void prep_gdn_item(const ScanBufs& sb, LAS unsigned char* lds, int b, int h, int c, PrepGRegs& R, const NextLoad& next_load) {
    const int tid = opaque((int)threadIdx.x), lane = tid & 63, wave = __builtin_amdgcn_readfirstlane(tid >> 6);
    LAS bf16* Raw = (LAS bf16*)lds;
    LAS bf16* Qs = (LAS bf16*)(lds + 53312); LAS bf16* Ks = Qs + 64 * 136; LAS bf16* Vs = Ks + 64 * 136;
    LAS float* KKf = (LAS float*)(lds + 105536); LAS float* QKf = KKf + 64 * 65;
    LAS float* CW = (LAS float*)(lds + 138816);
    LAS float* SCg = (LAS float*)(lds + 146496);
    LAS float* Lm = (LAS float*)lds;
    LAS bf16* Tout = (LAS bf16*)(lds + 32768);
    const int item = (b * 4 + h) * NCH + c;
    const float gga = R.ga, ggb = R.gb;
    const int tq = opaque(tid);
#pragma unroll
    for (int i = 0; i < 7; ++i) { const int idx = tq + i * NTHR;
        if (idx < 68 * 48) { const int rr = idx / 48, pc = idx % 48, sl = pc >> 4, off = (pc & 15) * 8; *(LAS u4v*)(Raw + rr * 392 + sl * 128 + off) = R.raw[i]; } }
    if (tq < 480) *(LAS f32x4*)(CW + tq * 4) = R.cw;
    next_load();
    LDS_BARRIER();
    for (int _d = 0; _d < (SCAN_DBL == 21 ? 2 : 1); ++_d) { const int t = tid >> 3, p = tid & 7;
#pragma unroll
      for (int sl = 0; sl < 3; ++sl) {
          float v[16]; float ss = 0.f;
#pragma unroll
          for (int e = 0; e < 16; ++e) v[e] = 0.f;
#pragma unroll
          for (int w = 0; w < 5; ++w) { const int ch0 = sl * 128 + 16 * p;
              const u4v r0 = *(const LAS u4v*)(Raw + (t + w) * 392 + ch0), r1 = *(const LAS u4v*)(Raw + (t + w) * 392 + ch0 + 8);
              float f0[8], f1[8]; unpack8(r0, f0); unpack8(r1, f1);
#pragma unroll
              for (int q4 = 0; q4 < 4; ++q4) { const f32x4 cwv = *(const LAS f32x4*)(CW + w * 384 + ch0 + q4 * 4);
#pragma unroll
                  for (int e = 0; e < 4; ++e) v[q4 * 4 + e] += (q4 < 2 ? f0[q4 * 4 + e] : f1[(q4 - 2) * 4 + e]) * cwv[e]; } }
#pragma unroll
          for (int e = 0; e < 16; ++e) { const float a = siluf_(v[e]); v[e] = a; ss += a * a; }
          if (sl < 2) { ss += dpp_f<0xB1>(ss); ss += dpp_f<0x4E>(ss); ss += dpp_f<0x141>(ss); const float r = rsqrtf(ss + EPS);
#pragma unroll
              for (int e = 0; e < 16; ++e) v[e] *= r; }
          LAS bf16* dst = (sl == 0 ? Qs : sl == 1 ? Ks : Vs) + t * 136 + 16 * p;
          *(LAS u4v*)dst = mk4(pk2(v[0], v[1]), pk2(v[2], v[3]), pk2(v[4], v[5]), pk2(v[6], v[7]));
          *(LAS u4v*)(dst + 8) = mk4(pk2(v[8], v[9]), pk2(v[10], v[11]), pk2(v[12], v[13]), pk2(v[14], v[15]));
      } }
    LDS_BARRIER();
    for (int _d = 0; _d < (SCAN_DBL == 22 ? 2 : 1); ++_d)
#pragma unroll
    for (int i = 0; i < 2; ++i) { const int idx = tid + i * NTHR;
        { const int t = idx >> 4, off = (idx & 15) * 8; *(u4v*)(sb.GQ + (size_t)item * 8192 + t * 128 + off) = *(const LAS u4v*)(Qs + t * 136 + off); }
        { const int dk = idx >> 3, t0 = (idx & 7) * 8; float f[8], g[8];
#pragma unroll
          for (int e = 0; e < 8; ++e) { f[e] = bf2f(Ks[(t0 + e) * 136 + dk]); g[e] = bf2f(Vs[(t0 + e) * 136 + dk]); }
          *(u4v*)(sb.GKT + (size_t)item * 8192 + dk * 64 + t0) = pack8(f); *(u4v*)(sb.GVT + (size_t)item * 8192 + dk * 64 + t0) = pack8(g); } }
    { const int rt = wave & 3; const LAS bf16* Am = wave < 4 ? Ks : Qs; LAS float* Out = wave < 4 ? KKf : QKf;
#pragma unroll
      for (int ct = 0; ct < 4; ++ct) { f32x4 acc = {0.f, 0.f, 0.f, 0.f};
#pragma unroll
          for (int ks = 0; ks < 4; ++ks) acc = MFMA16(ldfrag(Am, 136, 16 * rt, 32 * ks, lane), ldfrag(Ks, 136, 16 * ct, 32 * ks, lane), acc);
#pragma unroll
          for (int j = 0; j < 4; ++j) Out[(16 * rt + 4 * (lane >> 4) + j) * 65 + 16 * ct + (lane & 15)] = acc[j]; } }
    if (wave == 0 || wave == 4) {
        const int dir = wave >> 2, t = dir ? 63 - lane : lane; const int row = chunk_row(b, c, t, true);
        const float ga = gga, gb = ggb; (void)row;
        const LAS float* BT = (const LAS float*)(lds + 163840 - 512);
        float g = -__expf(BT[16 + dir * 4 + h]) * softplusf_(ga + BT[24 + dir * 4 + h]); const float beta = sigmoidf_(gb);
#pragma unroll
        for (int o = 1; o < 64; o <<= 1) { const float v = __shfl_up(g, o); if (lane >= o) g += v; }
        const float gend = __shfl(g, 63);
        SCg[(dir * 2) * 64 + t] = g; SCg[(dir * 2 + 1) * 64 + t] = beta;
        float* gs = sb.GSC + ((size_t)((b * 4 + h) * 2 + dir) * NCH + c) * GSCN;
        gs[t] = g; gs[64 + t] = beta * __expf(g); gs[128 + t] = beta; gs[192 + t] = __expf(gend - g); if (lane == 0) gs[256] = __expf(gend);
    }
    LDS_BARRIER();
    { const int t = tid >> 3, s0 = (tid & 7) * 8; float f[8];
#pragma unroll
      for (int e = 0; e < 8; ++e) f[e] = QKf[t * 65 + s0 + e];
      *(u4v*)(sb.GQK + (size_t)item * 4096 + t * 64 + s0) = pack8(f); }
    for (int idx = tid; idx < 2 * 4096; idx += NTHR) {
        const int dir = idx >> 12, p = (idx >> 6) & 63, q = idx & 63, tp = dir ? 63 - p : p, tq = dir ? 63 - q : q;
        const LAS float* Gd = SCg + (dir * 2) * 64;
        Lm[dir * 4096 + p * 64 + (q & 3) * 16 + (q >> 2)] = q < p ? Gd[64 + tp] * KKf[tp * 65 + tq] * __expf(Gd[tp] - Gd[tq]) : 0.f;
    }
    LDS_BARRIER();
    {
        const int dir = wave >> 2, col = (wave & 3) * 16 + (lane >> 2), pp = lane & 3;
        const LAS float* Ld = Lm + dir * 4096 + pp * 16;
        float Tq[16];
#pragma unroll
        for (int m = 0; m < 16; ++m) Tq[m] = 0.f;
        int lc = col; asm volatile("" : "+v"(lc));
#pragma unroll
        for (int i = 0; i < 64; ++i) {
            float s4[4] = {0.f, 0.f, 0.f, 0.f};
#pragma unroll
            for (int m4 = 0; m4 < (i + 15) / 16; ++m4) { const f32x4 l = *(const LAS f32x4*)(Ld + i * 64 + m4 * 4);
#pragma unroll
                for (int e = 0; e < 4; ++e) if (4 * (4 * m4 + e) < i) s4[e] += l[e] * Tq[4 * m4 + e]; }
            float s = (s4[0] + s4[1]) + (s4[2] + s4[3]);
            s += dpp_f<0xB1>(s); s += dpp_f<0x4E>(s);
            const float tv = ((lc == i) ? 1.f : 0.f) - s;
            if (pp == (i & 3)) Tq[i >> 2] = tv;
        }
        const int scol = dir ? 63 - col : col;
#pragma unroll
        for (int m = 0; m < 16; ++m) { const int i = 4 * m + pp; Tout[dir * 64 * 72 + (dir ? 63 - i : i) * 72 + scol] = f2bf(Tq[m]); }
    }
    LDS_BARRIER();
#pragma unroll
    for (int i = 0; i < 2; ++i) { const int idx = tid + i * NTHR, dir = idx >> 9, t = (idx >> 3) & 63, s0 = (idx & 7) * 8;
        *(u4v*)(sb.GT + ((size_t)((b * 4 + h) * 2 + dir) * NCH + c) * 4096 + t * 64 + s0) = *(const LAS u4v*)(Tout + dir * 64 * 72 + t * 72 + s0); }
    LDS_BARRIER();
}

__device__ __forceinline__ void scan_mlstm(const ScanBufs& sb, LAS unsigned char* lds, int b, int h, int dir, int hf) {
    const int tid0 = threadIdx.x, wave = __builtin_amdgcn_readfirstlane(tid0 >> 6);
    LAS bf16* Qs0 = (LAS bf16*)lds; LAS bf16* QKD0 = Qs0 + 2 * 4608; LAS bf16* KTW0 = QKD0 + 2 * 4608; LAS bf16* VT0 = KTW0 + 2 * 4608; LAS bf16* CT0 = VT0 + 2 * 4608;
    LAS float* SC0 = (LAS float*)(CT0 + 2 * 4608);
    LAS float* NV0 = SC0 + 3 * MSCN;
    LAS float* DEN0 = NV0 + 128;
    const int rt = wave >> 1;
    const size_t seq = (size_t)(b * 4 + h), dseq = seq * 2 + dir;
    struct Regs { u4v rq, rk, rqk, rv; f32x4 rsc; };
    Regs R0, R1; R0.rsc = (f32x4){0.f, 0.f, 0.f, 0.f}; R1.rsc = R0.rsc;
    auto chunk_of = [&](int ci) { return ci < 4 ? (dir ? 3 - ci : ci) : (dir ? NCH + 3 - ci : ci); };
    auto prefetch = [&](Regs& R, int ci) {
        const int tid = opaque(tid0), lane = tid & 63, fq = lane >> 4, fr = lane & 15, r = tid >> 3, c0 = (tid & 7) * 8; (void)fq; (void)fr; (void)r; (void)c0; (void)lane;
        if (ci >= NCH) return;
        const int c = chunk_of(ci); const size_t it = seq * NCH + c;
        R.rq = *(const u4v*)(sb.MQ + it * 4096 + r * 64 + c0); R.rk = *(const u4v*)(sb.MKT + it * 4096 + r * 64 + c0);
        R.rqk = *(const u4v*)(sb.MQK + it * 4096 + r * 64 + c0); R.rv = *(const u4v*)(sb.MVT + it * 8192 + (hf * 64 + r) * 64 + c0);
        if (tid < MSCN / 4) R.rsc = *(const f32x4*)(sb.MSC + (dseq * NCH + c) * MSCN + tid * 4);
    };
    auto put_sc = [&](const Regs& R, int ci) { const int tid = opaque(tid0); if (ci < NCH && tid < MSCN / 4) *(LAS f32x4*)(SC0 + (ci % 3) * MSCN + tid * 4) = R.rsc; };
    auto put_tiles = [&](const Regs& R, int ci) {
        const int tid = opaque(tid0), lane = tid & 63, fq = lane >> 4, fr = lane & 15, r = tid >> 3, c0 = (tid & 7) * 8; (void)fq; (void)fr; (void)r; (void)c0; (void)lane;
        if (ci >= NCH) return;
        const int p = ci & 1; const LAS float* SC = SC0 + (ci % 3) * MSCN;
        *(LAS u4v*)(Qs0 + p * 4608 + r * 72 + c0) = R.rq; *(LAS u4v*)(VT0 + p * 4608 + r * 72 + c0) = R.rv;
        float f[8], g[8], bs[8], is_[8], wsv[8]; unpack8(R.rqk, f); unpack8(R.rk, g); const float bt = SC[r];
        lds8(SC + c0, bs); lds8(SC + 64 + c0, is_); lds8(SC + 128 + c0, wsv);
#pragma unroll
        for (int e = 0; e < 8; ++e) { const int s = c0 + e; const bool le = dir ? (s >= r) : (s <= r);
            const float ex = __expf(le ? bt - bs[e] + is_[e] : 0.f); f[e] = le ? f[e] * ex : 0.f; g[e] *= wsv[e]; }
        *(LAS u4v*)(QKD0 + p * 4608 + r * 72 + c0) = pack8(f); *(LAS u4v*)(KTW0 + p * 4608 + r * 72 + c0) = pack8(g);
    };
    prefetch(R0, 0); prefetch(R1, 1);
    for (int i = tid0; i < 2 * 4608 / 2; i += NTHR) ((LAS unsigned*)CT0)[i] = 0u;
    if (tid0 < 128) NV0[tid0] = 0.f;
    put_sc(R0, 0); put_sc(R1, 1);
    LDS_BARRIER();
    put_tiles(R0, 0); prefetch(R0, 2);
    LDS_BARRIER();
    f32x4 Cacc[2] = {{0.f, 0.f, 0.f, 0.f}, {0.f, 0.f, 0.f, 0.f}};
    f32x4 oacc[2] = {{0.f, 0.f, 0.f, 0.f}, {0.f, 0.f, 0.f, 0.f}};
    int cprev = -1;
    auto step = [&](const int ci, Regs& Ra, Regs& Rb) {
        const int tid = opaque(tid0), lane = tid & 63, fq = lane >> 4, fr = lane & 15, r = tid >> 3, c0 = (tid & 7) * 8; (void)fq; (void)fr; (void)r; (void)c0; (void)lane;
        const int c = chunk_of(ci), p = ci & 1; const bool lat = c >= 4;
        const LAS float* SC = SC0 + (ci % 3) * MSCN;
        if (cprev >= 4) {
#pragma unroll
            for (int cc = 0; cc < 2; ++cc) { const int ct = 2 * (wave & 1) + cc, t = 16 * ct + fr; const float sc = 1.f / fmaxf(fabsf(DEN0[(p ^ 1) * 64 + t]), 1.f);
                const size_t row = (size_t)dir * T + chunk_row(b, cprev, t, false);
                *(u2v*)(sb.HML + row * 512 + h * 128 + hf * 64 + 16 * rt + 4 * fq) = mk2(pk2(oacc[cc][0] * sc, oacc[cc][1] * sc), pk2(oacc[cc][2] * sc, oacc[cc][3] * sc)); }
        }
        put_tiles(Ra, ci + 1); put_sc(Rb, ci + 2);
        prefetch(Ra, ci + 3);
        const LAS bf16* Qs = Qs0 + p * 4608; const LAS bf16* QKD = QKD0 + p * 4608; const LAS bf16* KTW = KTW0 + p * 4608; const LAS bf16* VT = VT0 + p * 4608;
        const float ebend = SC[320];
        if (lat) {
            { float f[8], nv[8]; float dot = 0.f; const u4v qq = *(const LAS u4v*)(Qs + r * 72 + c0); unpack8(qq, f); lds8(NV0 + p * 64 + c0, nv);
#pragma unroll
              for (int e = 0; e < 8; ++e) dot += f[e] * nv[e];
              dot += dpp_f<0xB1>(dot); dot += dpp_f<0x4E>(dot); dot += dpp_f<0x141>(dot);
              if ((tid & 7) == 0) DEN0[p * 64 + r] = SC[192 + r] + __expf(SC[r]) * dot; }
            bf16x8 cf[2], vf[2], qfr[2][2], df[2][2]; float eb[2];
#pragma unroll
            for (int ks = 0; ks < 2; ++ks) { cf[ks] = ldfrag(CT0 + p * 4608, 72, 16 * rt, 32 * ks, lane); vf[ks] = ldfrag(VT, 72, 16 * rt, 32 * ks, lane); }
#pragma unroll
            for (int cc = 0; cc < 2; ++cc) { const int ct = 2 * (wave & 1) + cc; eb[cc] = __expf(SC[16 * ct + fr]);
#pragma unroll
                for (int ks = 0; ks < 2; ++ks) { qfr[cc][ks] = ldfrag(Qs, 72, 16 * ct, 32 * ks, lane); df[cc][ks] = ldfrag(QKD, 72, 16 * ct, 32 * ks, lane); } }
#pragma unroll
            for (int cc = 0; cc < 2; ++cc) { oacc[cc] = (f32x4){0.f, 0.f, 0.f, 0.f};
#pragma unroll
                for (int ks = 0; ks < 2; ++ks) oacc[cc] = MFMA16(cf[ks], qfr[cc][ks], oacc[cc]); }
#pragma unroll
            for (int cc = 0; cc < 2; ++cc) {
#pragma unroll
                for (int j = 0; j < 4; ++j) oacc[cc][j] *= eb[cc];
#pragma unroll
                for (int ks = 0; ks < 2; ++ks) oacc[cc] = MFMA16(vf[ks], df[cc][ks], oacc[cc]); }
        }
        { bf16x8 kf[2], vf2[2][2];
#pragma unroll
          for (int ks = 0; ks < 2; ++ks) { kf[ks] = ldfrag(KTW, 72, 16 * rt, 32 * ks, lane);
#pragma unroll
              for (int cc = 0; cc < 2; ++cc) vf2[cc][ks] = ldfrag(VT, 72, 16 * (2 * (wave & 1) + cc), 32 * ks, lane); }
#pragma unroll
          for (int cc = 0; cc < 2; ++cc) {
#pragma unroll
              for (int j = 0; j < 4; ++j) Cacc[cc][j] *= ebend;
#pragma unroll
              for (int ks = 0; ks < 2; ++ks) Cacc[cc] = MFMA16(kf[ks], vf2[cc][ks], Cacc[cc]); } }
#pragma unroll
        for (int cc = 0; cc < 2; ++cc) { const int vt = 2 * (wave & 1) + cc;
            *(LAS u2v*)(CT0 + (p ^ 1) * 4608 + (16 * vt + fr) * 72 + 16 * rt + 4 * fq) = mk2(pk2(Cacc[cc][0], Cacc[cc][1]), pk2(Cacc[cc][2], Cacc[cc][3])); }
        if (tid < 64) NV0[(p ^ 1) * 64 + tid] = ebend * NV0[p * 64 + tid] + SC[256 + tid];
        cprev = c;
        LDS_BARRIER();
    };
    for (int ci = 0; ci < NCH; ci += 2) { step(ci, R1, R0); step(ci + 1, R0, R1); }
    if (cprev >= 4) {
        const int tid = opaque(tid0), lane = tid & 63, fq = lane >> 4, fr = lane & 15, r = tid >> 3, c0 = (tid & 7) * 8; (void)fq; (void)fr; (void)r; (void)c0; (void)lane;
#pragma unroll
        for (int cc = 0; cc < 2; ++cc) { const int ct = 2 * (wave & 1) + cc, t = 16 * ct + fr; const float sc = 1.f / fmaxf(fabsf(DEN0[((NCH - 1) & 1) * 64 + t]), 1.f);
            const size_t row = (size_t)dir * T + chunk_row(b, cprev, t, false);
            *(u2v*)(sb.HML + row * 512 + h * 128 + hf * 64 + 16 * rt + 4 * fq) = mk2(pk2(oacc[cc][0] * sc, oacc[cc][1] * sc), pk2(oacc[cc][2] * sc, oacc[cc][3] * sc)); }
    }
    LDS_BARRIER();
}

__device__ __forceinline__ void scan_gdn(const ScanBufs& sb, LAS unsigned char* lds, int b, int h, int dir, int hf) {
    const int tid0 = threadIdx.x, wave = __builtin_amdgcn_readfirstlane(tid0 >> 6);
    LAS bf16* KT0 = (LAS bf16*)lds;
    LAS bf16* QKD0 = (LAS bf16*)(lds + 36864);
    LAS bf16* VT = (LAS bf16*)(lds + 55296);
    LAS bf16* T1 = (LAS bf16*)(lds + 64512);
    LAS bf16* T2 = (LAS bf16*)(lds + 73728);
    LAS bf16* Wn = (LAS bf16*)(lds + 82944);
    LAS bf16* ST0 = (LAS bf16*)(lds + 100352);
    LAS bf16* VNT = (LAS bf16*)(lds + 135168);
    LAS bf16* VNS = (LAS bf16*)(lds + 144384);
    LAS float* SC0 = (LAS float*)(lds + 153600);
    const int tt2 = wave >> 1;
    const size_t seq = (size_t)(b * 4 + h), dseq = seq * 2 + dir;
    struct Regs { u4v rkt[2], rv, rqk, rtt; f32x4 rsc; u4v dum[2]; };
    Regs R0, R1; R0.rsc = (f32x4){0.f, 0.f, 0.f, 0.f}; R1.rsc = R0.rsc;
    auto chunk_of = [&](int ci) { return ci < 4 ? (dir ? 3 - ci : ci) : (dir ? NCH + 3 - ci : ci); };
    auto prefetch = [&](Regs& R, int ci) {
        const int tid = opaque(tid0), lane = tid & 63, fq = lane >> 4, fr = lane & 15, r = tid >> 3, c0 = (tid & 7) * 8; (void)fq; (void)fr; (void)r; (void)c0; (void)lane;
        if (ci >= NCH) return;
        const int c = chunk_of(ci); const size_t it = seq * NCH + c;
#pragma unroll
        for (int i = 0; i < 2; ++i) { const int idx = tid + i * NTHR; R.rkt[i] = *(const u4v*)(sb.GKT + it * 8192 + (idx >> 3) * 64 + (idx & 7) * 8); }
        R.rv = *(const u4v*)(sb.GVT + it * 8192 + (hf * 64 + r) * 64 + c0); R.rqk = *(const u4v*)(sb.GQK + it * 4096 + r * 64 + c0);
        R.rtt = *(const u4v*)(sb.GT + (dseq * NCH + c) * 4096 + r * 64 + c0);
#if SCAN_DBL == 51
#pragma unroll
        for (int i = 0; i < 2; ++i) { const int idx = tid + i * NTHR; R.dum[i] = *(const u4v*)(sb.GQ + it * 8192 + (idx >> 4) * 128 + (idx & 15) * 8); }
#endif
        if (tid < GSCN / 4) R.rsc = *(const f32x4*)(sb.GSC + (dseq * NCH + c) * GSCN + tid * 4);
    };
    auto put_sc = [&](const Regs& R, int ci) { const int tid = opaque(tid0); if (ci < NCH && tid < GSCN / 4) *(LAS f32x4*)(SC0 + (ci % 3) * GSCN + tid * 4) = R.rsc; };
    auto put_tiles = [&](const Regs& R, int ci) {
        const int tid = opaque(tid0), lane = tid & 63, fq = lane >> 4, fr = lane & 15, r = tid >> 3, c0 = (tid & 7) * 8; (void)fq; (void)fr; (void)r; (void)c0; (void)lane;
        if (ci >= NCH) return;
        const int p = ci & 1; const LAS float* SC = SC0 + (ci % 3) * GSCN;
#pragma unroll
        for (int i = 0; i < 2; ++i) { const int idx = tid + i * NTHR; *(LAS u4v*)(KT0 + p * 9216 + (idx >> 3) * 72 + (idx & 7) * 8) = R.rkt[i]; }
        *(LAS u4v*)(VT + r * 72 + c0) = R.rv;
#if SCAN_DBL == 51
        asm volatile("" :: "v"(R.dum[0]), "v"(R.dum[1]));
#endif
        float f[8], g[8], g2[8], Gs[8], bg[8], be[8]; unpack8(R.rqk, f); unpack8(R.rtt, g); const float Gt = SC[r];
        lds8(SC + c0, Gs); lds8(SC + 64 + c0, bg); lds8(SC + 128 + c0, be);
#pragma unroll
        for (int e = 0; e < 8; ++e) { const int s = c0 + e; const bool le = dir ? (s >= r) : (s <= r);
            const float ex = __expf(le ? Gt - Gs[e] : 0.f); f[e] = le ? f[e] * ex : 0.f; g2[e] = g[e] * be[e]; g[e] *= bg[e]; }
        *(LAS u4v*)(QKD0 + p * 4608 + r * 72 + c0) = pack8(f); *(LAS u4v*)(T1 + r * 72 + c0) = pack8(g); *(LAS u4v*)(T2 + r * 72 + c0) = pack8(g2);
    };
    f32x4 vacc[2];
    auto s1s2 = [&](int ci) {
        const int tid = opaque(tid0), lane = tid & 63, fq = lane >> 4, fr = lane & 15, r = tid >> 3, c0 = (tid & 7) * 8; (void)fq; (void)fr; (void)r; (void)c0; (void)lane;
        if (ci >= NCH) return;
        const LAS bf16* KT = KT0 + (ci & 1) * 9216;
        bf16x8 kf[2], t1f[4][2], t2f[2], vf[2][2];
#pragma unroll
        for (int ks = 0; ks < 2; ++ks) { kf[ks] = ldfrag(KT, 72, 16 * wave, 32 * ks, lane); t2f[ks] = ldfrag(T2, 72, 16 * tt2, 32 * ks, lane);
#pragma unroll
            for (int tt = 0; tt < 4; ++tt) t1f[tt][ks] = ldfrag(T1, 72, 16 * tt, 32 * ks, lane);
#pragma unroll
            for (int cc = 0; cc < 2; ++cc) vf[cc][ks] = ldfrag(VT, 72, 16 * (2 * (wave & 1) + cc), 32 * ks, lane); }
        f32x4 wacc[4];
#pragma unroll
        for (int tt = 0; tt < 4; ++tt) { wacc[tt] = (f32x4){0.f, 0.f, 0.f, 0.f};
#pragma unroll
            for (int ks = 0; ks < 2; ++ks) wacc[tt] = MFMA16(kf[ks], t1f[tt][ks], wacc[tt]); }
#pragma unroll
        for (int cc = 0; cc < 2; ++cc) { vacc[cc] = (f32x4){0.f, 0.f, 0.f, 0.f};
#pragma unroll
            for (int ks = 0; ks < 2; ++ks) vacc[cc] = MFMA16(t2f[ks], vf[cc][ks], vacc[cc]); }
#pragma unroll
        for (int tt = 0; tt < 4; ++tt) *(LAS u2v*)(Wn + (16 * tt + fr) * 136 + 16 * wave + 4 * fq) = mk2(pk2(-wacc[tt][0], -wacc[tt][1]), pk2(-wacc[tt][2], -wacc[tt][3]));
    };
    prefetch(R0, 0); prefetch(R1, 1);
    for (int i = tid0; i < 2 * 64 * 136 / 2; i += NTHR) ((LAS unsigned*)ST0)[i] = 0u;
    put_sc(R0, 0); put_sc(R1, 1);
    LDS_BARRIER();
    put_tiles(R0, 0); prefetch(R0, 2);
    LDS_BARRIER();
    s1s2(0);
    f32x4 Sacc[4];
#pragma unroll
    for (int i = 0; i < 4; ++i) Sacc[i] = (f32x4){0.f, 0.f, 0.f, 0.f};
    LDS_BARRIER();
    auto load_qf = [&](u4v (&qf)[4], int ci) {
        if (ci >= NCH) return;
        const int lane = opaque(tid0) & 63, fq = lane >> 4, fr = lane & 15;
        const bf16* gq = sb.GQ + (seq * NCH + chunk_of(ci)) * 8192;
#pragma unroll
        for (int ks = 0; ks < 4; ++ks) qf[ks] = *(const u4v*)(gq + (16 * (wave >> 1) + fr) * 128 + 32 * ks + 8 * fq); };
    u4v qfn[4];
    auto step = [&](const int ci, Regs& Ra, Regs& Rb) {
        const int tid = opaque(tid0), lane = tid & 63, fq = lane >> 4, fr = lane & 15, r = tid >> 3, c0 = (tid & 7) * 8; (void)fq; (void)fr; (void)r; (void)c0; (void)lane;
        const int c = chunk_of(ci), p = ci & 1; const bool lat = c >= 4;
        const LAS float* SC = SC0 + (ci % 3) * GSCN;
        put_tiles(Ra, ci + 1); put_sc(Rb, ci + 2);
        u4v qf[4];
#pragma unroll
        for (int ks = 0; ks < 4; ++ks) { qf[ks] = qfn[ks]; asm volatile("" : "+v"(qf[ks])); }
        prefetch(Ra, ci + 3); load_qf(qfn, ci + 1);
        const LAS bf16* ST = ST0 + p * 8704; const LAS bf16* KT = KT0 + p * 9216; const LAS bf16* QKD = QKD0 + p * 4608;
        bf16x8 sf[2][4];
        { bf16x8 wf[4];
#pragma unroll
          for (int ks = 0; ks < 4; ++ks) { wf[ks] = ldfrag(Wn, 136, 16 * tt2, 32 * ks, lane);
#pragma unroll
              for (int cc = 0; cc < 2; ++cc) sf[cc][ks] = ldfrag(ST, 136, 16 * (2 * (wave & 1) + cc), 32 * ks, lane); }
          const int tb = 16 * tt2 + 4 * fq; const f32x4 ege = *(const LAS f32x4*)(SC + 192 + tb);
#pragma unroll
          for (int ks = 0; ks < 4; ++ks)
#pragma unroll
              for (int cc = 0; cc < 2; ++cc) vacc[cc] = MFMA16(wf[ks], sf[cc][ks], vacc[cc]);
#pragma unroll
          for (int cc = 0; cc < 2; ++cc) { const int dvt = 2 * (wave & 1) + cc;
              *(LAS u2v*)(VNT + (16 * dvt + fr) * 72 + tb) = mk2(pk2(vacc[cc][0], vacc[cc][1]), pk2(vacc[cc][2], vacc[cc][3]));
              *(LAS u2v*)(VNS + (16 * dvt + fr) * 72 + tb) = mk2(pk2(vacc[cc][0] * ege[0], vacc[cc][1] * ege[1]), pk2(vacc[cc][2] * ege[2], vacc[cc][3] * ege[3])); } }
        LDS_BARRIER();
        const float egend = SC[256];
        { bf16x8 kf[2], nf[4][2];
#pragma unroll
          for (int ks = 0; ks < 2; ++ks) { kf[ks] = ldfrag(KT, 72, 16 * wave, 32 * ks, lane);
#pragma unroll
              for (int dvt = 0; dvt < 4; ++dvt) nf[dvt][ks] = ldfrag(VNS, 72, 16 * dvt, 32 * ks, lane); }
#pragma unroll
          for (int dvt = 0; dvt < 4; ++dvt) {
#pragma unroll
              for (int j = 0; j < 4; ++j) Sacc[dvt][j] *= egend;
#pragma unroll
              for (int ks = 0; ks < 2; ++ks) Sacc[dvt] = MFMA16(kf[ks], nf[dvt][ks], Sacc[dvt]); } }
#pragma unroll
        for (int dvt = 0; dvt < 4; ++dvt) {
            *(LAS u2v*)(ST0 + (p ^ 1) * 8704 + (16 * dvt + fr) * 136 + 16 * wave + 4 * fq) = mk2(pk2(Sacc[dvt][0], Sacc[dvt][1]), pk2(Sacc[dvt][2], Sacc[dvt][3])); }
        if (lat) {
            const int tt = wave >> 1, t = 16 * tt + fr;
            bf16x8 nf4[2][2], df4[2], qb[4];
#pragma unroll
            for (int ks = 0; ks < 4; ++ks) __builtin_memcpy(&qb[ks], &qf[ks], 16);
#pragma unroll
            for (int ks = 0; ks < 2; ++ks) { df4[ks] = ldfrag(QKD, 72, 16 * tt, 32 * ks, lane);
#pragma unroll
                for (int cc = 0; cc < 2; ++cc) nf4[cc][ks] = ldfrag(VNT, 72, 16 * (2 * (wave & 1) + cc), 32 * ks, lane); }
            const float eg = __expf(SC[t]);
            f32x4 acc[2] = {{0.f, 0.f, 0.f, 0.f}, {0.f, 0.f, 0.f, 0.f}};
#pragma unroll
            for (int ks = 0; ks < 4; ++ks)
#pragma unroll
                for (int cc = 0; cc < 2; ++cc) acc[cc] = MFMA16(sf[cc][ks], qb[ks], acc[cc]);
#pragma unroll
            for (int cc = 0; cc < 2; ++cc) {
#pragma unroll
                for (int j = 0; j < 4; ++j) acc[cc][j] *= eg;
#pragma unroll
                for (int ks = 0; ks < 2; ++ks) acc[cc] = MFMA16(nf4[cc][ks], df4[ks], acc[cc]); }
            const size_t row = (size_t)dir * T + chunk_row(b, c, t, true); const float qs = 0.08838834764831845f;
#pragma unroll
            for (int cc = 0; cc < 2; ++cc) { const int dvt = 2 * (wave & 1) + cc;
                *(u2v*)(sb.OGD + row * 512 + h * 128 + hf * 64 + 16 * dvt + 4 * fq) = mk2(pk2(acc[cc][0] * qs, acc[cc][1] * qs), pk2(acc[cc][2] * qs, acc[cc][3] * qs)); }
        }
        s1s2(ci + 1);
        LDS_BARRIER();
    };
    load_qf(qfn, 0);
    for (int ci = 0; ci < NCH; ci += 2) { step(ci, R1, R0); step(ci + 1, R0, R1); }
    LDS_BARRIER();
}

__global__ void __launch_bounds__(NTHR, 2) fwd(Args args) {
    extern __shared__ __attribute__((aligned(16))) unsigned char lds_raw[];
    LAS unsigned char* lds = (LAS unsigned char*)lds_raw;
    int tid = threadIdx.x, lane = tid & 63; const int wave = __builtin_amdgcn_readfirstlane(tid >> 6);
#define OPQ() asm volatile("" : "+v"(tid), "+v"(lane))
    const int G = gridDim.x, bid = blockIdx.x;
    const int gw = bid * NWAVE + wave, NGW = G * NWAVE;
    unsigned char* ws = args.ws;
    unsigned* ctl = (unsigned*)(ws + WS_CTL);
    float* MOD = (float*)(ws + WS_MOD);
    int* IDX = (int*)(ws + WS_IDX); float* GWT = (float*)(ws + WS_GWT); int* WCNT = (int*)(ws + WS_WCNT);
    int* LTOK = (int*)(ws + WS_LTOK); float* LW = (float*)(ws + WS_LW);
    int* TE = (int*)(ws + WS_TE);
    float* GATES = (float*)(ws + WS_GATES);
    bf16* WINT = (bf16*)(ws + WS_WINT); bf16* WOUTT = (bf16*)(ws + WS_WOUTT); unsigned char* WSGU8 = ws + WS_WSGU8; unsigned char* WSD8 = ws + WS_WSD8;
    unsigned char* WGU8 = ws + WS_WGU8; unsigned char* WD8 = ws + WS_WD8; unsigned char* HF8 = ws + WS_HF8;
    bf16* H = (bf16*)(ws + WS_H); bf16* PQK = (bf16*)(ws + WS_PQK); bf16* PV = (bf16*)(ws + WS_PV); bf16* PO = (bf16*)(ws + WS_PO);
    bf16* RAW = (bf16*)(ws + WS_RAW); bf16* PZ = (bf16*)(ws + WS_PZ); bf16* QKVP = (bf16*)(ws + WS_QKVP);
    ScanBufs sbf;
    sbf.PQK = PQK; sbf.PV = PV; sbf.RAW = RAW; sbf.GATES = GATES;
    sbf.MQ = (bf16*)(ws + WS_MQ); sbf.MKT = (bf16*)(ws + WS_MKT); sbf.MQK = (bf16*)(ws + WS_MQK); sbf.MVT = (bf16*)(ws + WS_MVT); sbf.MSC = (float*)(ws + WS_MSC);
    sbf.GQ = (bf16*)(ws + WS_GQ); sbf.GKT = (bf16*)(ws + WS_GKT); sbf.GVT = (bf16*)(ws + WS_GVT); sbf.GQK = (bf16*)(ws + WS_GQK); sbf.GT = (bf16*)(ws + WS_GT); sbf.GSC = (float*)(ws + WS_GSC);
    sbf.HML = (bf16*)(ws + WS_HML); sbf.OGD = (bf16*)(ws + WS_OGD);
    sbf.ib = args.in[I_MLIB]; sbf.fb = args.in[I_MLFB]; sbf.cw = args.in[I_GDCW]; sbf.alog = args.in[I_GDAL]; sbf.dtb = args.in[I_GDDT];
    bf16* HML = (bf16*)(ws + WS_HML); bf16* OGD = (bf16*)(ws + WS_OGD); bf16* YMIX = (bf16*)(ws + WS_YMIX); bf16* YLAT = (bf16*)(ws + WS_YLAT);
    bf16* HFFN = (bf16*)(ws + WS_HFFN); float* LOGH = (float*)(ws + WS_LOGH); float* LOGL = (float*)(ws + WS_LOGL); bf16* RWT = (bf16*)(ws + WS_RWT); unsigned char* CONTRIB = ws + WS_CONTRIB; int* LDST = (int*)(ws + WS_LDST);
    unsigned char* HBS8 = ws + WS_HBS8; unsigned char* HB8 = ws + WS_HB8; bf16* X1B = (bf16*)(ws + WS_X1B);
    const float* x = args.in[I_X]; float* out = args.out;

    volatile LAS unsigned* MISC = (volatile LAS unsigned*)(lds + 163840 - 256);
    if (tid < 16) MISC[tid] = 0u;
    __syncthreads();
    XcdBarrier bar; bar.bar = ctl + CW_BAR; bar.x = 0; bar.st = nullptr;
    if (N_LAUNCH_MODE == 1) bar = xcd_barrier_post(ctl + CW_BAR, MISC + 8);
    const int lo = args.ph_lo, hi = args.ph_hi;
#define IN(k) (lo <= (k) && (k) < hi)
#define REPS(k) ((k) == REP_PHASE ? REP_N : 1)
#define SEAM(k) do { if (N_LAUNCH_MODE == 1 && IN(k) && IN((k) + 1)) xcd_barrier(bar); } while (0)
    const bool own = (G == T / 256);
    const int ot0 = own ? 256 * bid + wave : gw, ots = own ? NWAVE : NGW, otend = own ? 256 * bid + 256 : T;
#define SEAM_OWN(k) do { if (own) __syncthreads(); else SEAM(k); } while (0)

    for (int _rep = 0; _rep < (IN(0) ? REPS(0) : 0); ++_rep) {
        LAS float* sc = (LAS float*)lds;
        LAS float* part = sc + 9 * 1024;
        const float* c = args.in[I_C]; const float* cctx = args.in[I_CCTX]; const float* wada = args.in[I_WADA]; const float* bada = args.in[I_BADA];
        for (int i = tid; i < 9 * 1024; i += NTHR) { const float v = (i < 8 * 1024) ? c[i] : cctx[i - 8 * 1024]; sc[i] = siluf_(v); }
        __syncthreads();
        for (int it = bid; it < 192; it += G) {
            const int cl = lane & 31, kpar = lane >> 5, col = it * 32 + cl;
            float acc[9];
#pragma unroll
            for (int r = 0; r < 9; ++r) acc[r] = 0.f;
#pragma unroll 16
            for (int j = 0; j < 64; ++j) {
                const int k = wave * 128 + 2 * j + kpar;
                const float w = wada[(size_t)k * 6144 + col];
#pragma unroll
                for (int r = 0; r < 9; ++r) acc[r] += sc[r * 1024 + k] * w;
            }
#pragma unroll
            for (int r = 0; r < 9; ++r) { acc[r] += __shfl_xor(acc[r], 32); if (kpar == 0) part[(wave * 9 + r) * 32 + cl] = acc[r]; }
            __syncthreads();
            for (int i = tid; i < 9 * 32; i += NTHR) {
                const int r = i >> 5, c2 = i & 31; float s = 0.f;
#pragma unroll
                for (int w = 0; w < 8; ++w) s += part[(w * 9 + r) * 32 + c2];
                MOD[r * 6144 + it * 32 + c2] = s + bada[it * 32 + c2];
            }
            __syncthreads();
        }
    }
    SEAM(0);
    OPQ();

    for (int _rep = 0; _rep < (IN(1) ? REPS(1) : 0); ++_rep) {
        {
            LAS float* scr = (LAS float*)(lds + wave * 16384);
            constexpr int I_IN = (D / 64) * (DIN / 32), I_OUT = (D / 64) * (D / 32), I_SG = (D / 64) * (DE / 32), I_SD = (DE / 64) * (D / 32);
            constexpr int N_RWI = (D / 64) * (NE / 32);
            constexpr int NIT = I_IN + I_OUT + 2 * I_SG + I_SD + 2 * N_RWI;
            for (int it = gw; it < NIT; it += NGW) {
                int r = it;
                if (r < I_IN) { transpose_item(args.in[I_WIN], D, DIN, WINT, scr, r, lane, [](int n, int& row, float& sc) {
                        sc = (n >= 256 && n < 512) ? 0.125f : 1.f;
                        row = n < 1536 ? n : n < 1552 ? 3584 + (n - 1536) : n < 3088 ? 1536 + (n - 1552) : n < 3600 ? 3072 + (n - 3088) : n; }); continue; }
                r -= I_IN;
                if (r < I_OUT) { transpose_item(args.in[I_WOUT], D, D, WOUTT, scr, r, lane, [](int n, int& row, float& sc) { sc = 1.f; row = n; }); continue; }
                r -= I_OUT;
                if (r < I_SG) { transpose_item_f8(args.in[I_WSG], D, DE, WSGU8, scr, r, lane, [](int n, int& row, float& sc) { sc = 64.f; row = 256 * (n >> 7) + (n & 127); }); continue; }
                r -= I_SG;
                if (r < I_SG) { transpose_item_f8(args.in[I_WSU], D, DE, WSGU8, scr, r, lane, [](int n, int& row, float& sc) { sc = 64.f; row = 256 * (n >> 7) + 128 + (n & 127); }); continue; }
                r -= I_SG;
                if (r < I_SD) { transpose_item_f8(args.in[I_WSD], DE, D, WSD8, scr, r, lane, [](int n, int& row, float& sc) { sc = 32.f; row = n; }); continue; }
                r -= I_SD;
                if (r < N_RWI) { transpose_item(args.in[I_RW], D, NE, RWT, scr, r, lane, [](int n, int& row, float& sc) { sc = 1.f; row = n; }); continue; }
                r -= N_RWI;
                transpose_item<true>(args.in[I_RW], D, NE, RWT, scr, r, lane, [](int n, int& row, float& sc) { sc = 1.f; row = 256 + n; });
            }
            for (int i = bid * NTHR + tid; i < (3840 - DIN) * D / 8; i += G * NTHR) *(uint4*)(WINT + (size_t)DIN * D + (size_t)i * 8) = make_uint4(0u, 0u, 0u, 0u);
        }
        const float* ctxp = args.in[I_CTX]; const float* wn = args.in[I_NPM];
        struct P1R { f32x4 v[4]; };
        auto p1_load = [&](P1R& R, int row) { const int r = row < TT ? row : gw; const float* src = r < T ? x + (size_t)r * D : ctxp + (size_t)(r - T) * D;
#pragma unroll
            for (int j = 0; j < 4; ++j) R.v[j] = *(const f32x4*)(src + j * 256 + lane * 4); };
        int pb = -1; float pa[16], ps[16];
        auto p1_row = [&](const P1R& R, int row) {
            if (row >= TT) return;
            const int b = row < T ? row / SEQ : 8;
            if (b != pb) { pb = b; const float* md = MOD + b * 6144;
#pragma unroll
                for (int j = 0; j < 4; ++j) { const f32x4 w4 = *(const f32x4*)(wn + j * 256 + lane * 4), s4 = *(const f32x4*)(md + 1024 + j * 256 + lane * 4), h4 = *(const f32x4*)(md + j * 256 + lane * 4);
#pragma unroll
                    for (int e = 0; e < 4; ++e) { pa[j * 4 + e] = w4[e] * (1.f + s4[e]); ps[j * 4 + e] = h4[e]; } } }
            float ss = 0.f;
#pragma unroll
            for (int j = 0; j < 4; ++j) ss += R.v[j].x * R.v[j].x + R.v[j].y * R.v[j].y + R.v[j].z * R.v[j].z + R.v[j].w * R.v[j].w;
            const float rstd = rsqrtf(wave_sum(ss) * (1.f / D) + EPS);
#pragma unroll
            for (int j = 0; j < 4; ++j) {
                const int cb = j * 256 + lane * 4; float o[4];
#pragma unroll
                for (int e = 0; e < 4; ++e) o[e] = R.v[j][e] * rstd * pa[j * 4 + e] + ps[j * 4 + e];
                *(uint2*)(H + (size_t)row * D + cb) = make_uint2((unsigned)f2bf(o[0]) | ((unsigned)f2bf(o[1]) << 16), (unsigned)f2bf(o[2]) | ((unsigned)f2bf(o[3]) << 16));
            } };
        P1R RA, RB; p1_load(RA, gw);
        for (int row = gw; row < TT; row += 2 * NGW) { p1_load(RB, row + NGW); p1_row(RA, row); p1_load(RA, row + 2 * NGW); p1_row(RB, row + NGW); }
    }
    SEAM(1);
    OPQ();

    for (int _rep = 0; _rep < (IN(2) ? REPS(2) : 0); ++_rep) {
        pg::DenseOrder S{(const char*)H, (const char*)WINT, 2 * D, TT / 256, 15, (TT / 256) * 15, G, bid};
        pg::EpiP2 E{PQK, PV, PO, RAW, PZ, GATES};
        pg::gemm_phase<pg::EpiP2, pg::DenseOrder, false>(lds, 2 * D, S, E);
#if REP_GEMM == 2
        pg::gemm_phase<pg::EpiP2, pg::DenseOrder, false>(lds, 2 * D, S, E); pg::gemm_phase<pg::EpiP2, pg::DenseOrder, false>(lds, 2 * D, S, E);
#endif
    }
    SEAM(2);
    OPQ();

    for (int _rep = 0; _rep < (IN(3) ? REPS(3) : 0); ++_rep) {
        constexpr int NIT3 = NB * 4 * NCH;
        if (tid < 32) { const float* srcp = tid < 8 ? sbf.ib : tid < 16 ? sbf.fb : tid < 24 ? sbf.alog : sbf.dtb; ((LAS float*)(lds + 163840 - 512))[tid] = srcp[tid & 7]; }
        __syncthreads();
        {
            PrepMRegs R; int it = bid;
            if (it < NIT3) prep_mlstm_load(sbf, R, it / (4 * NCH), (it / NCH) & 3, it % NCH);
            for (; it < NIT3; it += G) {
                const int nx = it + G;
                prep_mlstm_item(sbf, lds, it / (4 * NCH), (it / NCH) & 3, it % NCH, R, [&]() { if (nx < NIT3) prep_mlstm_load(sbf, R, nx / (4 * NCH), (nx / NCH) & 3, nx % NCH); });
            }
        }
#if SCAN_DBL == 41
        {
            PrepMRegs R; int it = bid;
            if (it < NIT3) prep_mlstm_load(sbf, R, it / (4 * NCH), (it / NCH) & 3, it % NCH);
            for (; it < NIT3; it += G) {
                const int nx = it + G;
                prep_mlstm_item(sbf, lds, it / (4 * NCH), (it / NCH) & 3, it % NCH, R, [&]() { if (nx < NIT3) prep_mlstm_load(sbf, R, nx / (4 * NCH), (nx / NCH) & 3, nx % NCH); });
            }
        }
#endif
        {
            PrepGRegs R; int it = bid;
            if (it < NIT3) prep_gdn_load(sbf, R, it / (4 * NCH), (it / NCH) & 3, it % NCH);
            for (; it < NIT3; it += G) {
                const int nx = it + G;
                prep_gdn_item(sbf, lds, it / (4 * NCH), (it / NCH) & 3, it % NCH, R, [&]() { if (nx < NIT3) prep_gdn_load(sbf, R, nx / (4 * NCH), (nx / NCH) & 3, nx % NCH); });
            }
        }
#if SCAN_DBL == 42
        {
            PrepGRegs R; int it = bid;
            if (it < NIT3) prep_gdn_load(sbf, R, it / (4 * NCH), (it / NCH) & 3, it % NCH);
            for (; it < NIT3; it += G) {
                const int nx = it + G;
                prep_gdn_item(sbf, lds, it / (4 * NCH), (it / NCH) & 3, it % NCH, R, [&]() { if (nx < NIT3) prep_gdn_load(sbf, R, nx / (4 * NCH), (nx / NCH) & 3, nx % NCH); });
            }
        }
#endif
    }
    SEAM(3);
    OPQ();

    for (int _rep = 0; _rep < (IN(4) ? REPS(4) : 0); ++_rep) {
        for (int it = bid; it < 256; it += G) {
            const int hf = (it >> 3) & 1, sq = ((it >> 4) << 3) | (it & 7), kind = sq >> 6, b = (sq >> 3) & 7, h = (sq >> 1) & 3, dir = sq & 1;
            if (kind == 0) { scan_gdn(sbf, lds, b, h, dir, hf);
#if SCAN_DBL == 11
                scan_gdn(sbf, lds, b, h, dir, hf);
#endif
            } else { scan_mlstm(sbf, lds, b, h, dir, hf);
#if SCAN_DBL == 12
                scan_mlstm(sbf, lds, b, h, dir, hf);
#endif
            }
        }
    }
    SEAM(4);
    OPQ();

    for (int _rep = 0; _rep < (IN(5) ? REPS(5) : 0); ++_rep) {
        const float* mlnw = args.in[I_MLNW]; const float* gdnw = args.in[I_GDNW];
        const bool ml = lane < 32; const int c16 = (lane & 31) * 16;
        const float* gp = ml ? mlnw + c16 : gdnw + (c16 & 127);
        float gn[16];
#pragma unroll
        for (int i = 0; i < 4; ++i) { const f32x4 g4 = *(const f32x4*)(gp + 4 * i); gn[4 * i] = g4[0]; gn[4 * i + 1] = g4[1]; gn[4 * i + 2] = g4[2]; gn[4 * i + 3] = g4[3]; }
        struct P5R { u4v l[6]; };
        auto p5_load = [&](P5R& R, int t) { const int tn = t < otend ? t : ot0;
            const bf16* s0 = (ml ? HML : OGD) + (size_t)tn * 512 + c16; const bf16* s1 = s0 + (size_t)T * 512; const bf16* gs = (ml ? PO : PZ) + (size_t)tn * 512 + c16;
            R.l[0] = *(const u4v*)s0; R.l[1] = *(const u4v*)(s0 + 8); R.l[2] = *(const u4v*)s1; R.l[3] = *(const u4v*)(s1 + 8); R.l[4] = *(const u4v*)gs; R.l[5] = *(const u4v*)(gs + 8); };
        auto p5_row = [&](const P5R& R, int t) {
            if (t >= otend) return;
            float v[16], w[16], z[16];
            { float f[8]; unpack8(R.l[0], f);
#pragma unroll
              for (int i = 0; i < 8; ++i) v[i] = f[i];
              unpack8(R.l[1], f);
#pragma unroll
              for (int i = 0; i < 8; ++i) v[8 + i] = f[i];
              unpack8(R.l[2], f);
#pragma unroll
              for (int i = 0; i < 8; ++i) w[i] = f[i];
              unpack8(R.l[3], f);
#pragma unroll
              for (int i = 0; i < 8; ++i) w[8 + i] = f[i];
              unpack8(R.l[4], f);
#pragma unroll
              for (int i = 0; i < 8; ++i) z[i] = f[i];
              unpack8(R.l[5], f);
#pragma unroll
              for (int i = 0; i < 8; ++i) z[8 + i] = f[i]; }
            float ss = 0.f;
#pragma unroll
            for (int i = 0; i < 16; ++i) { v[i] += w[i]; ss += v[i] * v[i]; }
            ss += dpp_f<0xB1>(ss); ss += dpp_f<0x4E>(ss); ss += dpp_f<0x141>(ss);
            const float r = rsqrtf(ss * (1.f / 128.f) + EPS);
            float o[16];
#pragma unroll
            for (int i = 0; i < 16; ++i) { const float act = ml ? sigmoidf_(z[i]) : siluf_(z[i]); o[i] = v[i] * r * gn[i] * act; }
            float o0[8], o1[8];
#pragma unroll
            for (int i = 0; i < 8; ++i) { o0[i] = o[i]; o1[i] = o[8 + i]; }
            *(u4v*)(YMIX + (size_t)t * D + lane * 16) = pack8(o0); *(u4v*)(YMIX + (size_t)t * D + lane * 16 + 8) = pack8(o1); };
        P5R RA, RB; p5_load(RA, ot0);
        for (int t = ot0; t < otend; t += 2 * ots) { p5_load(RB, t + ots); p5_row(RA, t); p5_load(RA, t + 2 * ots); p5_row(RB, t + ots); }
    }
    SEAM_OWN(5);
    OPQ();

    for (int _rep = 0; _rep < (IN(6) ? REPS(6) : 0); ++_rep) {
        pg::DenseOrder S{(const char*)YMIX, (const char*)WOUTT, 2 * D, T / 256, 4, (T / 256) * 4, G, bid, own ? 1 : 0};
        pg::EpiBf16 E{YLAT, D};
        pg::gemm_phase<pg::EpiBf16, pg::DenseOrder, false>(lds, 2 * D, S, E);
#if REP_GEMM == 6
        pg::gemm_phase<pg::EpiBf16, pg::DenseOrder, false>(lds, 2 * D, S, E); pg::gemm_phase<pg::EpiBf16, pg::DenseOrder, false>(lds, 2 * D, S, E);
#endif
    }
    SEAM_OWN(6);
    OPQ();

    for (int _rep = 0; _rep < (IN(7) ? REPS(7) : 0); ++_rep) {
        const float* wq = args.in[I_NQM]; const float* wf = args.in[I_NPF];
        struct P7R { uint2 u[4]; f32x4 xx[4]; };
        auto p7_load = [&](P7R& R, int row) { const int r = row < otend ? row : ot0;
#pragma unroll
            for (int j = 0; j < 4; ++j) { R.u[j] = *(const uint2*)(YLAT + (size_t)r * D + j * 256 + lane * 4); R.xx[j] = *(const f32x4*)(x + (size_t)r * D + j * 256 + lane * 4); } };
        int pb = -1; float pg1[16], pa2[16], ps2[16];
        auto p7_row = [&](const P7R& R, int row) {
            if (row >= otend) return;
            { const int b = row / SEQ;
              if (b != pb) { pb = b; const float* md = MOD + b * 6144;
#pragma unroll
                for (int j = 0; j < 4; ++j) { const int cb = j * 256 + lane * 4;
                    const f32x4 g4 = *(const f32x4*)(md + 2048 + cb), q4 = *(const f32x4*)(wq + cb), f4 = *(const f32x4*)(wf + cb), s4 = *(const f32x4*)(md + 4096 + cb), h4 = *(const f32x4*)(md + 3072 + cb);
#pragma unroll
                    for (int e = 0; e < 4; ++e) { pg1[j * 4 + e] = g4[e] * q4[e]; pa2[j * 4 + e] = f4[e] * (1.f + s4[e]); ps2[j * 4 + e] = h4[e]; } } } }
            float yv[16], xv[16]; float ss = 0.f;
#pragma unroll
            for (int j = 0; j < 4; ++j) { const uint2 u = R.u[j];
                yv[j * 4] = bf2f((bf16)(u.x & 0xffffu)); yv[j * 4 + 1] = bf2f((bf16)(u.x >> 16)); yv[j * 4 + 2] = bf2f((bf16)(u.y & 0xffffu)); yv[j * 4 + 3] = bf2f((bf16)(u.y >> 16)); }
#pragma unroll
            for (int i = 0; i < 16; ++i) ss += yv[i] * yv[i];
            const float r1 = rsqrtf(wave_sum(ss) * (1.f / D) + EPS);
            float s2 = 0.f;
#pragma unroll
            for (int j = 0; j < 4; ++j) { const f32x4 xx = R.xx[j];
#pragma unroll
                for (int e = 0; e < 4; ++e) { const float v = xx[e] + pg1[j * 4 + e] * (yv[j * 4 + e] * r1); xv[j * 4 + e] = v; s2 += v * v; } }
            const float r2 = rsqrtf(wave_sum(s2) * (1.f / D) + EPS);
#pragma unroll
            for (int j = 0; j < 4; ++j) { f32x4 o, hf;
#pragma unroll
                for (int e = 0; e < 4; ++e) { o[e] = xv[j * 4 + e]; hf[e] = xv[j * 4 + e] * r2 * pa2[j * 4 + e] + ps2[j * 4 + e]; }
                *(uint2*)(X1B + (size_t)row * D + j * 256 + lane * 4) = make_uint2((unsigned)f2bf(o[0]) | ((unsigned)f2bf(o[1]) << 16), (unsigned)f2bf(o[2]) | ((unsigned)f2bf(o[3]) << 16));
                *(uint2*)(HFFN + (size_t)row * D + j * 256 + lane * 4) = make_uint2((unsigned)f2bf(hf[0]) | ((unsigned)f2bf(hf[1]) << 16), (unsigned)f2bf(hf[2]) | ((unsigned)f2bf(hf[3]) << 16));
                { int p8 = 0; p8 = __builtin_amdgcn_cvt_pk_fp8_f32(hf[0], hf[1], p8, false); p8 = __builtin_amdgcn_cvt_pk_fp8_f32(hf[2], hf[3], p8, true); *(int*)(HF8 + (size_t)row * D + j * 256 + lane * 4) = p8; } } };
        P7R RA, RB; p7_load(RA, ot0);
        for (int row = ot0; row < otend; row += 2 * ots) { p7_load(RB, row + ots); p7_row(RA, row); p7_load(RA, row + 2 * ots); p7_row(RB, row + ots); }
    }
    SEAM_OWN(7);
    OPQ();

    for (int _rep = 0; _rep < (IN(8) ? REPS(8) : 0); ++_rep) {
        pg::DenseOrder S{(const char*)HFFN, (const char*)RWT, 2 * D, T / 256, ROUTER_LO ? 2 : 1, (T / 256) * (ROUTER_LO ? 2 : 1), G, bid, own ? 1 : 0};
        pg::EpiF32 E{LOGH, LOGL, 256};
        pg::gemm_phase<pg::EpiF32, pg::DenseOrder, false>(lds, 2 * D, S, E);
#if REP_GEMM == 8
        pg::gemm_phase<pg::EpiF32, pg::DenseOrder, false>(lds, 2 * D, S, E); pg::gemm_phase<pg::EpiF32, pg::DenseOrder, false>(lds, 2 * D, S, E);
#endif
    }
    SEAM_OWN(8);
    OPQ();

    for (int _rep = 0; _rep < (IN(9) ? REPS(9) : 0); ++_rep) {
        LAS unsigned* HIST = (LAS unsigned*)lds;
        if (own) { if (tid < NE) HIST[tid] = 0u; __syncthreads(); }
        auto drain_conv = [&]() {
            LAS float* scr = (LAS float*)(lds + 8192 + wave * 17408);
            for (;;) { unsigned c = 0; if (lane == 0) c = atomicAdd(&ctl[CW_CQA], 1u); c = __builtin_amdgcn_readfirstlane(c); if (c >= (unsigned)NCQA) break;
                conv_chunk(args.in[I_WG], args.in[I_WU], args.in[I_WD], WGU8, WD8, scr, 0, (int)c, lane); }
            for (;;) { unsigned c = 0; if (lane == 0) c = atomicAdd(&ctl[CW_CQB], 1u); c = __builtin_amdgcn_readfirstlane(c); if (c >= (unsigned)NCQB) break;
                conv_chunk(args.in[I_WG], args.in[I_WU], args.in[I_WD], WGU8, WD8, scr, 1, (int)c, lane); } };
        if (wave >= 4) drain_conv();
        const float* rb = args.in[I_RB];
        LAS float* selb = (LAS float*)lds + wave * 256;
        struct TKR { f32x4 hi, lo; };
        const int kt0 = own ? 256 * bid + (wave & 3) : bid * 4 + (wave & 3), kts = own ? 4 : G * 4, ktend = own ? 256 * bid + 256 : T;
        auto tk_load = [&](TKR& R, int t) { const int tc = t < ktend ? t : kt0; R.hi = *(const f32x4*)(LOGH + (size_t)tc * 256 + lane * 4); if (ROUTER_LO) R.lo = *(const f32x4*)(LOGL + (size_t)tc * 256 + lane * 4); };
        const f32x4 rb4 = *(const f32x4*)(rb + lane * 4);
        auto tk_tok = [&](const TKR& R, int t) {
            if (t >= ktend) return;
            f32x4 lg = R.hi; if (ROUTER_LO) lg += R.lo;
            float sc[4], sel[4];
#pragma unroll
            for (int e = 0; e < 4; ++e) { sc[e] = sigmoidf_(lg[e]); sel[e] = sc[e] + rb4[e]; }
            float m1 = fmaxf(sel[0], sel[1]), m2 = fminf(sel[0], sel[1]);
#pragma unroll
            for (int e = 2; e < 4; ++e) { const float v = sel[e]; m2 = fmaxf(m2, fminf(m1, v)); m1 = fmaxf(m1, v); }
#pragma unroll
            for (int o = 1; o < 8; o <<= 1) {
                const float o1 = o == 1 ? dpp_f<0xB1>(m1) : o == 2 ? dpp_f<0x4E>(m1) : dpp_f<0x141>(m1), o2 = o == 1 ? dpp_f<0xB1>(m2) : o == 2 ? dpp_f<0x4E>(m2) : dpp_f<0x141>(m2);
                m2 = fmaxf(fminf(m1, o1), fmaxf(m2, o2)); m1 = fmaxf(m1, o1); }
            const float mygs = m1 + m2; const int myg = lane >> 3;
            int rank = 0;
#pragma unroll
            for (int j = 0; j < 8; ++j) { const float o = readlane_f(mygs, j * 8); rank += (o > mygs || (o == mygs && j < myg)) ? 1 : 0; }
            const bool gsel = rank < 4;
#pragma unroll
            for (int e = 0; e < 4; ++e) if (!gsel) sel[e] = -INFINITY;
            float gsum = 0.f; float myw = 0.f; int myi = 0;
#pragma unroll
            for (int r = 0; r < 8; ++r) {
                float bv = sel[0]; int be = 0; float bsl = sc[0];
#pragma unroll
                for (int e = 1; e < 4; ++e) if (sel[e] > bv) { bv = sel[e]; be = e; bsl = sc[e]; }
                const float wm = wave_max_all(bv);
                const unsigned long long mk = __ballot(bv == wm);
                const int srcl = __builtin_amdgcn_readfirstlane((int)__builtin_ctzll(mk));
                const int bi = srcl * 4 + __builtin_amdgcn_readlane(be, srcl); const float bs = __builtin_bit_cast(float, __builtin_amdgcn_readlane(__builtin_bit_cast(int, bsl), srcl));
                gsum += bs; if (lane == r) { myw = bs; myi = bi; }
#pragma unroll
                for (int e = 0; e < 4; ++e) if (bi == lane * 4 + e) sel[e] = -INFINITY;
            }
            if (lane < 8) { IDX[(size_t)t * 8 + lane] = myi; GWT[(size_t)t * 8 + lane] = myw / gsum * 2.5f;
                if (own) __hip_atomic_fetch_add(&HIST[myi], 1u, __ATOMIC_RELAXED, __HIP_MEMORY_SCOPE_WORKGROUP); else atomicAdd(&ctl[CW_CNT + myi], 1u); }
        };
        if (wave < 4) { TKR RA, RB; tk_load(RA, kt0);
            for (int t = kt0; t < ktend; t += 2 * kts) { tk_load(RB, t + kts); tk_tok(RA, t); tk_load(RA, t + 2 * kts); tk_tok(RB, t + kts); } }
        if (wave < 4) drain_conv();
        if (own) { __syncthreads(); if (tid < NE) WCNT[tid * 256 + bid] = (int)HIST[tid]; }
    }
    SEAM(9);
    OPQ();

    for (int _rep = 0; _rep < ((IN(11) && own) ? 1 : 0); ++_rep) {
        LAS unsigned* OFFL = (LAS unsigned*)lds;
        LAS unsigned* WT = OFFL + 520;
        LAS unsigned* CUR = OFFL + 1024;
        LAS unsigned* TOT = OFFL + 1536;
        { const int e2 = tid >> 1, hf = tid & 1; const int* wrow = WCNT + e2 * 256 + hf * 128; unsigned tot = 0, pre = 0;
#pragma unroll 8
          for (int k = 0; k < 32; ++k) { const int4 v = *(const int4*)(wrow + 4 * k); const int w0 = hf * 128 + 4 * k;
              tot += (unsigned)(v.x + v.y + v.z + v.w); pre += (unsigned)((w0 < bid ? v.x : 0) + (w0 + 1 < bid ? v.y : 0) + (w0 + 2 < bid ? v.z : 0) + (w0 + 3 < bid ? v.w : 0)); }
          tot += __shfl_xor(tot, 1); pre += __shfl_xor(pre, 1);
          if (hf == 0) { TOT[e2] = tot; CUR[e2] = pre; } }
        __syncthreads();
        const unsigned cnt = tid < NE ? TOT[tid] : 0u, ntile = (cnt + 255u) >> 8;
        unsigned incl = ntile;
#pragma unroll
        for (int o = 1; o < 64; o <<= 1) { const unsigned v = __shfl_up(incl, o); if (lane >= o) incl += v; }
        if (lane == 63) WT[wave] = incl;
        __syncthreads();
        unsigned base = 0;
#pragma unroll
        for (int w = 0; w < 8; ++w) base += (w < wave) ? WT[w] : 0u;
        const unsigned toff = base + incl - ntile;
        if (tid < NE) { OFFL[tid] = toff * 256u; CUR[tid] += toff * 256u; }
        if (bid == 0 && tid == NE - 1) { const unsigned tt = toff + ntile; ctl[CW_NRT] = tt < (unsigned)(CAPROWS / 256) ? tt : (unsigned)(CAPROWS / 256); }
        __syncthreads();
        if (bid < NE) {
            const unsigned ce = TOT[bid], nte = (ce + 255u) >> 8, offe = OFFL[bid];
            if ((unsigned)tid < nte && offe / 256u + tid < (unsigned)(CAPROWS / 256)) TE[offe / 256u + tid] = bid;
            const unsigned p = ce + tid; if (p < nte * 256u) { const unsigned q = offe + p; if (q < (unsigned)CAPROWS) { LTOK[q] = 0; LW[q] = 0.f; LDST[q] = -1; } }
        }
        for (int j = tid; j < 2048; j += NTHR) {
            const int t = 256 * bid + (j >> 3); const size_t i = (size_t)t * 8 + (j & 7); const int e = IDX[i];
            const unsigned pos = __hip_atomic_fetch_add(&CUR[e], 1u, __ATOMIC_RELAXED, __HIP_MEMORY_SCOPE_WORKGROUP);
            if (pos < (unsigned)CAPROWS) { LTOK[pos] = t; LW[pos] = GWT[i]; LDST[pos] = t * 9 + (j & 7); }
        }
        __syncthreads();
    }
    for (int _rep = 0; _rep < ((IN(11) && !own) ? 1 : 0); ++_rep) {
        LAS unsigned* OFFL = (LAS unsigned*)lds;
        LAS unsigned* WT = OFFL + 520;
        const unsigned cnt = tid < NE ? ctl[CW_CNT + tid] : 0u, ntile = (cnt + 255u) >> 8;
        unsigned incl = ntile;
#pragma unroll
        for (int o = 1; o < 64; o <<= 1) { const unsigned v = __shfl_up(incl, o); if (lane >= o) incl += v; }
        if (lane == 63) WT[wave] = incl;
        __syncthreads();
        unsigned base = 0;
#pragma unroll
        for (int w = 0; w < 8; ++w) base += (w < wave) ? WT[w] : 0u;
        const unsigned toff = base + incl - ntile;
        if (tid < NE) OFFL[tid] = toff * 256u;
        if (bid == 0 && tid < NE) {
            for (unsigned s = 0; s < ntile; ++s) if (toff + s < (unsigned)(CAPROWS / 256)) TE[toff + s] = tid;
            if (tid == NE - 1) { const unsigned tot = toff + ntile; ctl[CW_NRT] = tot < (unsigned)(CAPROWS / 256) ? tot : (unsigned)(CAPROWS / 256); }
            for (unsigned p = cnt; p < ntile * 256u; ++p) { const unsigned q = toff * 256u + p; if (q < (unsigned)CAPROWS) { LTOK[q] = 0; LW[q] = 0.f; LDST[q] = -1; } }
        }
        __syncthreads();
        for (long i = (long)bid * NTHR + tid; i < (long)T * 8; i += (long)G * NTHR) {
            const int t = (int)(i >> 3), e = IDX[i]; const unsigned pos = OFFL[e] + atomicAdd(&ctl[CW_FILL + e], 1u);
            if (pos < (unsigned)CAPROWS) { LTOK[pos] = t; LW[pos] = GWT[i]; LDST[pos] = t * 9 + (int)(i & 7); }
        }
        __syncthreads();
    }
    SEAM(11);
    OPQ();

    for (int _rep = 0; _rep < (IN(12) ? REPS(12) : 0); ++_rep) {
        { LAS int* tel = (LAS int*)(lds + pg::TE_OFF); for (int i = tid; i < CAPROWS / 256; i += NTHR) tel[i] = TE[i]; __syncthreads(); }
        {
            pg::DenseOrder S{(const char*)HF8, (const char*)WSGU8, D, T / 256, 2, (T / 256) * 2, G, bid};
            pg::EpiGU8 E{HBS8};
            pg::gemm_phase<pg::EpiGU8, pg::DenseOrder, false, true>(lds, D, S, E);
#if REP_GEMM == 120
        pg::gemm_phase<pg::EpiGU8, pg::DenseOrder, false, true>(lds, D, S, E); pg::gemm_phase<pg::EpiGU8, pg::DenseOrder, false, true>(lds, D, S, E);
#endif
        }
        {
            const int nrt = (int)ctl[CW_NRT];
            pg::RoutedGuOrder S{(const char*)HF8, (const char*)WGU8, LTOK, (const LAS int*)(lds + pg::TE_OFF), D, nrt * 2, G, bid};
            pg::EpiGU8 E{HB8};
            pg::gemm_phase<pg::EpiGU8, pg::RoutedGuOrder, true, true>(lds, D, S, E);
#if REP_GEMM == 121
        pg::gemm_phase<pg::EpiGU8, pg::RoutedGuOrder, true, true>(lds, D, S, E); pg::gemm_phase<pg::EpiGU8, pg::RoutedGuOrder, true, true>(lds, D, S, E);
#endif
        }
    }
    SEAM(12);
    OPQ();

    if (IN(13)) {
        { LAS int* tel = (LAS int*)(lds + pg::TE_OFF); for (int i = tid; i < CAPROWS / 256; i += NTHR) tel[i] = TE[i]; __syncthreads(); }
        {
            pg::DenseOrder S{(const char*)HBS8, (const char*)WSD8, DE, T / 256, 4, (T / 256) * 4, G, bid};
            pg::EpiContrib<true> E{CONTRIB, nullptr, nullptr};
            pg::gemm_phase<pg::EpiContrib<true>, pg::DenseOrder, false, true>(lds, DE, S, E);
        }
        {
            const int nrt = (int)ctl[CW_NRT];
            pg::RoutedDownOrder S{(const char*)HB8, (const char*)WD8, (const LAS int*)(lds + pg::TE_OFF), DE, 0, nrt * 4, G, bid};
            pg::EpiContrib<false> E{CONTRIB, LDST, LW};
            pg::gemm_phase<pg::EpiContrib<false>, pg::RoutedDownOrder, false, true>(lds, DE, S, E);
#if REP_GEMM == 131
            pg::gemm_phase<pg::EpiContrib<false>, pg::RoutedDownOrder, false, true>(lds, DE, S, E); pg::gemm_phase<pg::EpiContrib<false>, pg::RoutedDownOrder, false, true>(lds, DE, S, E);
#endif
#if REP_GEMM == 132
            { pg::EpiContrib<false, true> E2{CONTRIB, LDST, LW};
              pg::gemm_phase<pg::EpiContrib<false, true>, pg::RoutedDownOrder, false, true>(lds, DE, S, E2); pg::gemm_phase<pg::EpiContrib<false, true>, pg::RoutedDownOrder, false, true>(lds, DE, S, E2); }
#endif
        }
    }
    SEAM(13);
    OPQ();

    if (IN(14)) {
        const float* wq = args.in[I_NQF];
        typedef float f32x2 __attribute__((ext_vector_type(2)));
        struct P14R { u4v cr[9], x1[2]; };
        auto p14_load = [&](P14R& R, int row) { const int r = row < T ? row : gw;
#pragma unroll
            for (int s = 0; s < 9; ++s) R.cr[s] = *(const u4v*)(CONTRIB + ((size_t)r * 9 + s) * 1024 + lane * 16);
            R.x1[0] = *(const u4v*)(X1B + (size_t)r * D + lane * 16); R.x1[1] = *(const u4v*)(X1B + (size_t)r * D + lane * 16 + 8); };
        int pb = -1; float pg[16];
        auto p14_row = [&](const P14R& R, int row) {
            if (row >= T) return;
            { const int b = row / SEQ;
              if (b != pb) { pb = b; const float* md = MOD + b * 6144;
#pragma unroll
                for (int q4 = 0; q4 < 4; ++q4) { const f32x4 g4 = *(const f32x4*)(md + 5120 + lane * 16 + q4 * 4), w4 = *(const f32x4*)(wq + lane * 16 + q4 * 4);
#pragma unroll
                    for (int e = 0; e < 4; ++e) pg[q4 * 4 + e] = g4[e] * w4[e]; } } }
            float y[16];
#pragma unroll
            for (int i = 0; i < 16; ++i) y[i] = 0.f;
#pragma unroll
            for (int s = 0; s < 9; ++s) {
#pragma unroll
                for (int q4 = 0; q4 < 4; ++q4) { const int wd = (int)R.cr[s][q4]; const f32x2 lo = __builtin_amdgcn_cvt_pk_f32_fp8(wd, false), hi = __builtin_amdgcn_cvt_pk_f32_fp8(wd, true);
                    y[q4 * 4] += lo.x; y[q4 * 4 + 1] += lo.y; y[q4 * 4 + 2] += hi.x; y[q4 * 4 + 3] += hi.y; }
            }
            float ss = 0.f;
#pragma unroll
            for (int i = 0; i < 16; ++i) ss += y[i] * y[i];
            const float r1 = rsqrtf(wave_sum(ss) * (1.f / (D * 256.f)) + EPS) * (1.f / 16.f);
            float x1f[16]; { float f[8]; unpack8(R.x1[0], f);
#pragma unroll
              for (int i = 0; i < 8; ++i) x1f[i] = f[i];
              unpack8(R.x1[1], f);
#pragma unroll
              for (int i = 0; i < 8; ++i) x1f[8 + i] = f[i]; }
#pragma unroll
            for (int q4 = 0; q4 < 4; ++q4) { const int cb = lane * 16 + q4 * 4; f32x4 xx = {x1f[q4 * 4], x1f[q4 * 4 + 1], x1f[q4 * 4 + 2], x1f[q4 * 4 + 3]};
#pragma unroll
                for (int e = 0; e < 4; ++e) xx[e] += pg[q4 * 4 + e] * (y[q4 * 4 + e] * r1);
                *(f32x4*)(out + (size_t)row * D + cb) = xx; } };
        P14R RA, RB; p14_load(RA, gw);
        for (int row = gw; row < T; row += 2 * NGW) { p14_load(RB, row + NGW); p14_row(RA, row); p14_load(RA, row + 2 * NGW); p14_row(RB, row + NGW); }
    }
#undef IN
#undef SEAM
}

constexpr int LDS_BYTES = 163840;
extern "C" void kernel_launch(void* const* d_in, const int* in_sizes, int n_in, void* d_out, int out_size, void* d_ws, size_t ws_size, hipStream_t stream) {
    static int grid = 0;
    if (grid == 0) {
        if (n_in != 27 || out_size != T * D || ws_size < WS_END) { fprintf(stderr, "kernel_launch: unexpected shapes n_in %d out %d ws %zu (need %zu)\n", n_in, out_size, ws_size, (size_t)WS_END); grid = -1; return; }
        int dev = 0, cus = 0, per_cu = 0;
        if (hipGetDevice(&dev) != hipSuccess || hipDeviceGetAttribute(&cus, hipDeviceAttributeMultiprocessorCount, dev) != hipSuccess) { grid = -1; return; }
        if (hipFuncSetAttribute((const void*)fwd, hipFuncAttributeMaxDynamicSharedMemorySize, LDS_BYTES) != hipSuccess) { fprintf(stderr, "kernel_launch: hipFuncSetAttribute failed\n"); grid = -1; return; }
        if (hipOccupancyMaxActiveBlocksPerMultiprocessor(&per_cu, (const void*)fwd, NTHR, LDS_BYTES) != hipSuccess || per_cu < 1) fprintf(stderr, "kernel_launch: occupancy query says %d\n", per_cu);
        (void)hipGetLastError();
        grid = cus;
    }
    if (grid < 0) return;
    (void)hipMemsetAsync((char*)d_ws + WS_CTL, 0, CTL_ZERO_BYTES, stream);
    Args a{};
    for (int i = 0; i < 27; ++i) a.in[i] = (const float*)d_in[i];
    a.out = (float*)d_out; a.ws = (unsigned char*)d_ws;
    if (N_LAUNCH_MODE == 1) { a.ph_lo = 0; a.ph_hi = NPHASE; hipLaunchKernelGGL(fwd, dim3(grid), dim3(NTHR), LDS_BYTES, stream, a); }
    else for (int p = 0; p < NPHASE; ++p) { a.ph_lo = p; a.ph_hi = p + 1; hipLaunchKernelGGL(fwd, dim3(grid), dim3(NTHR), LDS_BYTES, stream, a); }
}
```
